# Optimizing an MI355X kernel written in HIP

```python
import math
import jax, jax.numpy as jnp
from jax import lax
import numpy as np

D_MODEL = 1024
BATCH = 16
SEQ = 2048
DEPTH = 1

CHUNK = 64
Q_BLOCK = 128

FOX_HEADS = 8
FOX_HEAD_DIM = 64
FOX_WIDTH = FOX_HEADS * FOX_HEAD_DIM

GLA_HEADS = 4
GLA_KEY_DIM = 128
GLA_VAL_DIM = 256
GLA_QK_WIDTH = GLA_HEADS * GLA_KEY_DIM
GLA_V_WIDTH = GLA_HEADS * GLA_VAL_DIM
GLA_GATE_RANK = 16
GLA_GATE_TEMP = 16.0
GLA_NORM_EPS = 1e-5

PEER_HEADS = 8
PEER_N_KEYS = 128
PEER_N_EXPERTS = PEER_N_KEYS * PEER_N_KEYS
PEER_QUERY_DIM = 256
PEER_HALF = PEER_QUERY_DIM // 2
PEER_TOPK = 16
PEER_TOKEN_BLOCK = 128

ALPHA = (2.0 * DEPTH) ** 0.25
BETA = (8.0 * DEPTH) ** -0.25
LN_EPS = 1e-5

IN_SPLIT_SIZES = (FOX_WIDTH, FOX_WIDTH, FOX_WIDTH, FOX_HEADS,
                  GLA_QK_WIDTH, GLA_QK_WIDTH, GLA_V_WIDTH, GLA_V_WIDTH, GLA_GATE_RANK,
                  D_MODEL, D_MODEL)
IN_WIDTH = sum(IN_SPLIT_SIZES)
IN_SPLIT_POINTS = tuple(int(v) for v in np.cumsum(IN_SPLIT_SIZES)[:-1])

kernel_name = "hybrid_fox_gla_peer_block"


def layer_norm(x, gain, bias):
    xf = x.astype(jnp.float32)
    mu = jnp.mean(xf, axis=-1, keepdims=True)
    var = jnp.mean(jnp.square(xf - mu), axis=-1, keepdims=True)
    y = (xf - mu) * lax.rsqrt(var + LN_EPS)
    return (y * gain.astype(jnp.float32) + bias.astype(jnp.float32)).astype(x.dtype)


def fox_attention(q, k, v, f_logit):
    B, S, H, dh = q.shape
    log_f = jax.nn.log_sigmoid(f_logit.astype(jnp.float32))
    c = jnp.cumsum(log_f, axis=1).transpose(0, 2, 1)
    scale = dh ** -0.5
    outs = []
    for i in range(S // Q_BLOCK):
        q0, q1 = i * Q_BLOCK, (i + 1) * Q_BLOCK
        qb, kb, vb = q[:, q0:q1], k[:, :q1], v[:, :q1]
        logits = jnp.einsum('bqhd,bkhd->bhqk', qb, kb).astype(jnp.float32) * scale
        logits = logits + c[:, :, q0:q1, None] - c[:, :, None, :q1]
        q_pos = jnp.arange(q0, q1)[:, None]
        k_pos = jnp.arange(q1)[None, :]
        logits = jnp.where(k_pos <= q_pos, logits, -jnp.inf)
        probs = jax.nn.softmax(logits, axis=-1).astype(v.dtype)
        outs.append(jnp.einsum('bhqk,bkhd->bqhd', probs, vb))
    return jnp.concatenate(outs, axis=1)


def gla_chunk_attention(q, k, v, log_a):
    B, S, H, dk = q.shape
    dv = v.shape[-1]
    nc = S // CHUNK

    def to_chunks(t):
        return t.reshape(B, nc, CHUNK, *t.shape[2:]).swapaxes(0, 1)

    la = to_chunks(log_a)
    cum = jnp.cumsum(la, axis=2)
    total = cum[:, :, -1]
    k_dec = to_chunks(k).astype(jnp.float32) * jnp.exp(total[:, :, None] - cum)
    qc = to_chunks(q).astype(jnp.float32)
    vc = to_chunks(v).astype(jnp.float32)

    def step(state, inp):
        q_c, k_c, v_c, tot = inp
        state = state * jnp.exp(tot)[..., None] + jnp.einsum('bchk,bchv->bhkv', k_c, v_c)
        o_c = jnp.einsum('bchk,bhkv->bchv', q_c, state)
        return state, o_c

    init = jnp.zeros((B, H, dk, dv), jnp.float32)
    _, o = lax.scan(step, init, (qc, k_dec, vc, total))
    return o.swapaxes(0, 1).reshape(B, S, H, dv)


def peer_layer(h, w_query, sub_keys, expert_u, expert_v):
    B, S, D = h.shape
    T = B * S
    ht = h.reshape(T, D)
    q = jnp.einsum('td,dhq->thq', ht, w_query).reshape(T, PEER_HEADS, 2, PEER_HALF)
    scores = jnp.einsum('thpc,hpnc->thpn', q, sub_keys).astype(jnp.float32)
    s_top, i_top = lax.top_k(scores, PEER_TOPK)
    cand = (s_top[:, :, 0, :, None] + s_top[:, :, 1, None, :]).reshape(T, PEER_HEADS, PEER_TOPK * PEER_TOPK)
    cand_idx = (i_top[:, :, 0, :, None] * PEER_N_KEYS + i_top[:, :, 1, None, :]).reshape(T, PEER_HEADS, PEER_TOPK * PEER_TOPK)
    best, pos = lax.top_k(cand, PEER_TOPK)
    expert_idx = jnp.take_along_axis(cand_idx, pos, axis=-1)
    gates = jax.nn.softmax(best, axis=-1).astype(h.dtype)

    nb = T // PEER_TOKEN_BLOCK
    hb = ht.reshape(nb, PEER_TOKEN_BLOCK, D)
    ib = expert_idx.reshape(nb, PEER_TOKEN_BLOCK, PEER_HEADS * PEER_TOPK)
    gb = gates.reshape(nb, PEER_TOKEN_BLOCK, PEER_HEADS * PEER_TOPK)

    def block(args):
        h_blk, i_blk, g_blk = args
        u = expert_u[i_blk]
        vv = expert_v[i_blk]
        act = jax.nn.gelu(jnp.einsum('td,tkd->tk', h_blk, u), approximate=False)
        return jnp.einsum('tk,tkd->td', act * g_blk, vv)

    out = lax.map(block, (hb, ib, gb))
    return out.reshape(B, S, D)


def setup_inputs(seed: int = 0) -> dict:
    key = jax.random.key(seed)
    ks = jax.random.split(key, 17)
    f32 = jnp.float32
    nrm = lambda k, shape: jax.random.normal(k, shape, f32)
    L = DEPTH
    return {
        "x": nrm(ks[0], (BATCH, SEQ, D_MODEL)),
        "w_in": nrm(ks[1], (L, D_MODEL, IN_WIDTH)) * D_MODEL ** -0.5,
        "fox_f_bias": 3.0 + 0.5 * nrm(ks[2], (L, FOX_HEADS)),
        "gla_gate_up": nrm(ks[3], (L, GLA_GATE_RANK, GLA_QK_WIDTH)) * GLA_GATE_RANK ** -0.5,
        "gla_gate_bias": 0.1 * nrm(ks[4], (L, GLA_QK_WIDTH)),
        "gla_norm_gain": 1.0 + 0.02 * nrm(ks[5], (L, GLA_HEADS, GLA_VAL_DIM)),
        "w_out_fox": nrm(ks[6], (L, FOX_WIDTH, D_MODEL)) * FOX_WIDTH ** -0.5,
        "w_out_gla": nrm(ks[7], (L, GLA_V_WIDTH, D_MODEL)) * GLA_V_WIDTH ** -0.5,
        "w_out": nrm(ks[8], (L, D_MODEL, D_MODEL)) * (D_MODEL ** -0.5 * BETA),
        "ln1_gain": 1.0 + 0.02 * nrm(ks[9], (L, D_MODEL)),
        "ln1_bias": 0.02 * nrm(ks[10], (L, D_MODEL)),
        "peer_w_query": nrm(ks[11], (L, D_MODEL, PEER_HEADS, PEER_QUERY_DIM)) * D_MODEL ** -0.5,
        "peer_sub_keys": nrm(ks[12], (L, PEER_HEADS, 2, PEER_N_KEYS, PEER_HALF)) * PEER_HALF ** -0.5,
        "peer_expert_u": nrm(ks[13], (L, PEER_N_EXPERTS, D_MODEL)) * D_MODEL ** -0.5,
        "peer_expert_v": nrm(ks[14], (L, PEER_N_EXPERTS, D_MODEL)) * BETA,
        "ln2_gain": 1.0 + 0.02 * nrm(ks[15], (L, D_MODEL)),
        "ln2_bias": 0.02 * nrm(ks[16], (L, D_MODEL)),
    }


def reference(x, w_in, fox_f_bias, gla_gate_up, gla_gate_bias, gla_norm_gain, w_out_fox, w_out_gla,
              w_out, ln1_gain, ln1_bias, peer_w_query, peer_sub_keys, peer_expert_u, peer_expert_v,
              ln2_gain, ln2_bias):
    B, S, D = x.shape
    for l in range(DEPTH):
        proj = jnp.einsum('bsd,de->bse', x, w_in[l])
        (fq, fk, fv, ff, gq, gk, gv, gg, glr, mga, mgb) = jnp.split(proj, IN_SPLIT_POINTS, axis=-1)

        y_fox = fox_attention(fq.reshape(B, S, FOX_HEADS, FOX_HEAD_DIM),
                              fk.reshape(B, S, FOX_HEADS, FOX_HEAD_DIM),
                              fv.reshape(B, S, FOX_HEADS, FOX_HEAD_DIM),
                              ff + fox_f_bias[l])
        y_fox = jnp.einsum('bsf,fd->bsd', y_fox.reshape(B, S, FOX_WIDTH), w_out_fox[l])

        log_a = jax.nn.log_sigmoid((glr @ gla_gate_up[l] + gla_gate_bias[l]).astype(jnp.float32)) / GLA_GATE_TEMP
        o = gla_chunk_attention((gq * GLA_KEY_DIM ** -0.5).reshape(B, S, GLA_HEADS, GLA_KEY_DIM),
                                gk.reshape(B, S, GLA_HEADS, GLA_KEY_DIM),
                                gv.reshape(B, S, GLA_HEADS, GLA_VAL_DIM),
                                log_a.reshape(B, S, GLA_HEADS, GLA_KEY_DIM))
        o = o * lax.rsqrt(jnp.mean(jnp.square(o), axis=-1, keepdims=True) + GLA_NORM_EPS) * gla_norm_gain[l].astype(jnp.float32)
        o = o.reshape(B, S, GLA_V_WIDTH).astype(x.dtype) * jax.nn.silu(gg)
        y_gla = jnp.einsum('bsv,vd->bsd', o, w_out_gla[l])

        merged = jax.nn.sigmoid(mga) * y_fox + jax.nn.sigmoid(mgb) * y_gla
        mix = jnp.einsum('bsd,de->bse', merged, w_out[l])
        x = layer_norm(ALPHA * x + mix, ln1_gain[l], ln1_bias[l])

        ffn = peer_layer(x, peer_w_query[l], peer_sub_keys[l], peer_expert_u[l], peer_expert_v[l])
        x = layer_norm(ALPHA * x + ffn, ln2_gain[l], ln2_bias[l])
    return x
```

```cpp
#define MK_X5 1
#include <hip/hip_runtime.h>
#include <hip/hip_bf16.h>
#include <cstdio>
#include <cstdint>
#include <cmath>
namespace pg8 {
#define PG8_LAS __attribute__((address_space(3)))
typedef unsigned short bf16_t;
typedef short bf16x8 __attribute__((ext_vector_type(8)));
typedef float f32x4 __attribute__((ext_vector_type(4)));
typedef unsigned u32x4 __attribute__((ext_vector_type(4)));
constexpr int BM = 256, BK = 64, HALF = 128, HTB = HALF * BK * 2  , STAGE_BYTES = 8 * HTB, NXCD = 8, WGM = 8;

__host__ __device__ __forceinline__ int lds_byte(int r, int c) { const int st = (r >> 4) * 2 + (c >> 5), rr = r & 15, cc = c & 31, ob = rr * 64 + cc * 2; return st * 1024 + (ob ^ (((ob >> 9) & 1) << 5)); }
__host__ __device__ __forceinline__ void stage_rc(int b, int& R, int& C) { const int st = b / 1024, sb = b % 1024, swz = sb ^ (((sb >> 9) & 1) << 5); R = (st >> 1) * 16 + swz / 64; C = (st & 1) * 32 + (swz % 64) / 2; }
__host__ __device__ __forceinline__ int perm32(int rho) { const int n = rho >> 4, i = rho & 15; return 8 * (i >> 2) + 4 * n + (i & 3); }

struct Unit { int pm, pn; };
struct Gemm { const bf16_t* A; const bf16_t* Bt; int M, N, K; };

struct StaticOrder {
    int nM, nN, nwg, G, c;
    __host__ __device__ void init(int M, int N, int G_, int c_) { nM = M / BM; nN = N / BM; nwg = nM * nN; G = G_; c = c_; }
    __host__ __device__ bool next(int i, Unit& u) const {
        const long L = (long)i * G + c; if (L >= nwg) return false;
        int wgid = (int)L; { const int q = nwg / NXCD, r = nwg % NXCD, xcd = wgid % NXCD, off = wgid / NXCD; wgid = (xcd < r ? xcd * (q + 1) : r * (q + 1) + (xcd - r) * q) + off; }
        const int nig = WGM * nN, gid = wgid / nig, fm = gid * WGM, gsz = (nM - fm) < WGM ? (nM - fm) : WGM;
        u.pm = fm + ((wgid % nig) % gsz); u.pn = (wgid % nig) / gsz; return true;
    }
    __device__ __forceinline__ void a_ready(const Unit&) const {}
    __device__ __forceinline__ void done(const Unit&) const {}
};

__device__ __forceinline__ unsigned cvt_pk_bf16(float lo, float hi) { unsigned r; asm volatile("v_cvt_pk_bf16_f32 %0, %1, %2" : "=v"(r) : "v"(lo), "v"(hi)); return r; }
typedef float f32x2 __attribute__((ext_vector_type(2)));
__device__ __forceinline__ f32x2 gelu_pk(f32x2 v) {
    const f32x2 av = __builtin_elementwise_abs(v), d = av * 0.2316418882f + 1.0f;
    f32x2 t; t.x = __builtin_amdgcn_rcpf(d.x); t.y = __builtin_amdgcn_rcpf(d.y);
    f32x2 q = t * 0.5307027145f + (-0.7265760135f); q = q * t + 0.7107068705f; q = q * t + (-0.142248368f); q = q * t + 0.127414796f; q = q * t;
    const f32x2 s = (v * v) * (-0.72134752044f);
    f32x2 e; e.x = __builtin_amdgcn_exp2f(s.x); e.y = __builtin_amdgcn_exp2f(s.y);
    const f32x2 m = v * (q * e), r = v - m;
    f32x2 o; o.x = v.x < 0.f ? m.x : r.x; o.y = v.y < 0.f ? m.y : r.y; return o;
}

template <int ACT  > struct EpiBf16 {
    static constexpr bool PERM = true, AFTER_DRAIN = false; static_assert(ACT == 0 || ACT == 1, "EpiBf16: ACT is 0 (none) or 1 (gelu_pk)");
    bf16_t* O; int ldc; const float* bias; int split_cols; size_t split_stride; float scale0;
    __device__ __forceinline__ void operator()(const f32x4 (&acc)[2][2][4][2], const Unit& u, int wr, int wc, int fr, int fq) const {
        const int row0 = u.pm * BM + wr * 64 + fr; int colt = u.pn * BM; bf16_t* base = O;
        float sc = 1.f; if (split_cols) { const int t = colt / split_cols; base += (size_t)t * split_stride; colt -= t * split_cols; if (t == 0) sc = scale0; }
        const int col0 = colt + wc * 32 + 8 * fq, bcol0 = u.pn * BM + wc * 32 + 8 * fq;
        f32x4 bv[2][2];
#pragma unroll
        for (int bj = 0; bj < 2; ++bj)
#pragma unroll
            for (int n = 0; n < 2; ++n) bv[bj][n] = bias ? *(const f32x4*)(bias + bcol0 + bj * HALF + 4 * n) : (f32x4){0.f, 0.f, 0.f, 0.f};
#pragma unroll
        for (int ai = 0; ai < 2; ++ai)
#pragma unroll
            for (int m = 0; m < 4; ++m) { bf16_t* rowp = base + (size_t)(row0 + ai * HALF + m * 16) * ldc + col0;
#pragma unroll
                for (int bj = 0; bj < 2; ++bj) { f32x4 v0 = acc[ai][bj][m][0] + bv[bj][0], v1 = acc[ai][bj][m][1] + bv[bj][1];
                    if (ACT == 1) { f32x2 a = gelu_pk((f32x2){v0[0], v0[1]}), b = gelu_pk((f32x2){v0[2], v0[3]}), c = gelu_pk((f32x2){v1[0], v1[1]}), d = gelu_pk((f32x2){v1[2], v1[3]});
                        v0 = (f32x4){a.x, a.y, b.x, b.y}; v1 = (f32x4){c.x, c.y, d.x, d.y}; }
                    v0 = v0 * sc; v1 = v1 * sc; u32x4 w; w.x = cvt_pk_bf16(v0[0], v0[1]); w.y = cvt_pk_bf16(v0[2], v0[3]); w.z = cvt_pk_bf16(v1[0], v1[1]); w.w = cvt_pk_bf16(v1[2], v1[3]);
                    *(u32x4*)(rowp + bj * HALF) = w; } }
    }
};

struct PanelStats {
    unsigned* xbuf;
    unsigned* cnt;
    unsigned* tmo;
    int ntn; float eps;
    unsigned code;
    __device__ __forceinline__ bool run(const f32x4 (&v)[2][2][4][2], const Unit& u, int wr, int wc, int fr, int fq, PG8_LAS unsigned char* lds, int wid, int lane) const {
        typedef float f32x2v __attribute__((ext_vector_type(2)));
        PG8_LAS f32x2v* P = (PG8_LAS f32x2v*)lds;
        PG8_LAS f32x2v* S = (PG8_LAS f32x2v*)(lds + 8192);
        PG8_LAS unsigned* flag = (PG8_LAS unsigned*)(lds + 8192 + 2048);
#pragma unroll
        for (int ai = 0; ai < 2; ++ai)
#pragma unroll
            for (int m = 0; m < 4; ++m) {
                float s = 0.f;
#pragma unroll
                for (int bj = 0; bj < 2; ++bj)
#pragma unroll
                    for (int n = 0; n < 2; ++n) { const f32x4 x = v[ai][bj][m][n]; s += (x[0] + x[1]) + (x[2] + x[3]); }
                s += __shfl_xor(s, 16); s += __shfl_xor(s, 32);
                const float mw = s * (1.0f / 64.0f); float q = 0.f;
#pragma unroll
                for (int bj = 0; bj < 2; ++bj)
#pragma unroll
                    for (int n = 0; n < 2; ++n) { const f32x4 d = v[ai][bj][m][n] - mw; q += (d[0] * d[0] + d[1] * d[1]) + (d[2] * d[2] + d[3] * d[3]); }
                q += __shfl_xor(q, 16); q += __shfl_xor(q, 32);
                if (fq == 0) P[(ai * HALF + wr * 64 + m * 16 + fr) * 4 + wc] = (f32x2v){mw, q};
            }
        asm volatile("s_waitcnt lgkmcnt(0)" ::: "memory"); __builtin_amdgcn_s_barrier(); asm volatile("" ::: "memory");
#if defined(BROKEN_EXCHANGE_NO_WAIT)
#warning BROKEN CONTROL BUILD: the row-statistics exchange does not wait; results are wrong by design
        if (blockIdx.x >= 64) { const long long t0_ = clock64(); while (clock64() - t0_ < 60000) __builtin_amdgcn_s_sleep(8); }
#endif
        const int row = wid * 32 + (lane & 31);
        if (lane < 32) {
            const f32x2v a = P[row * 4 + 0], b = P[row * 4 + 1], c = P[row * 4 + 2], d = P[row * 4 + 3];
            const float mt = (a.x + b.x + c.x + d.x) * 0.25f;
            const float da = a.x - mt, db = b.x - mt, dc = c.x - mt, dd = d.x - mt;
            const float m2 = (a.y + b.y) + (c.y + d.y) + 64.0f * ((da * da + db * db) + (dc * dc + dd * dd));
            unsigned long long* slot = (unsigned long long*)xbuf + ((size_t)(u.pm * BM + row) * 4 + u.pn);
            __hip_atomic_store(slot, ((unsigned long long)__float_as_uint(m2) << 32) | __float_as_uint(mt), __ATOMIC_RELAXED, __HIP_MEMORY_SCOPE_AGENT);
        }
        asm volatile("s_waitcnt vmcnt(0)" ::: "memory");
        if (lane == 0) __hip_atomic_fetch_add(cnt + 64 * u.pm, 1u, __ATOMIC_RELAXED, __HIP_MEMORY_SCOPE_AGENT);
        if (wid == 0) {
            bool dead = false; const unsigned long long t0 = __builtin_amdgcn_s_memrealtime(); const unsigned want = 8u * (unsigned)ntn;
            for (;;) {
#if defined(BROKEN_EXCHANGE_NO_WAIT)
                break;
#endif
                if ((unsigned)__builtin_amdgcn_readfirstlane(__hip_atomic_load(cnt + 64 * u.pm, __ATOMIC_RELAXED, __HIP_MEMORY_SCOPE_AGENT)) >= want) break;
                if (__builtin_amdgcn_s_memrealtime() - t0 > 2000000ull) {
                    if (lane == 0) { unsigned expect = 0u; __hip_atomic_compare_exchange_strong(tmo + 1, &expect, code | (unsigned)(u.pm & 0xff), __ATOMIC_RELAXED, __ATOMIC_RELAXED, __HIP_MEMORY_SCOPE_AGENT);
                                     __hip_atomic_store(tmo, 1u, __ATOMIC_RELAXED, __HIP_MEMORY_SCOPE_AGENT); }
                    dead = true; break; }
                __builtin_amdgcn_s_sleep(2);
            }
            __builtin_amdgcn_fence(__ATOMIC_ACQUIRE, "agent");
            if (lane == 0) flag[0] = dead ? 1u : 0u;
        }
        asm volatile("s_waitcnt vmcnt(0) lgkmcnt(0)" ::: "memory"); __builtin_amdgcn_s_barrier(); asm volatile("" ::: "memory");
        const bool bad = flag[0] != 0u;
        if (lane < 32) {
            const unsigned long long* slot = (const unsigned long long*)xbuf + (size_t)(u.pm * BM + row) * 4; float mt[4], m2[4]; float ms = 0.f;
#pragma unroll
            for (int t = 0; t < 4; ++t) { if (t < ntn) { const unsigned long long w = __hip_atomic_load(slot + t, __ATOMIC_RELAXED, __HIP_MEMORY_SCOPE_AGENT); mt[t] = __uint_as_float((unsigned)w); m2[t] = __uint_as_float((unsigned)(w >> 32)); } else { mt[t] = 0.f; m2[t] = 0.f; } ms += mt[t]; }
            const float mean = ms / (float)ntn; float q = 0.f;
#pragma unroll
            for (int t = 0; t < 4; ++t) if (t < ntn) { const float dm = mt[t] - mean; q += m2[t] + 256.0f * dm * dm; }
            S[row] = (f32x2v){mean, 1.0f / sqrtf(q / (256.0f * (float)ntn) + eps)};
        }
        asm volatile("s_waitcnt lgkmcnt(0)" ::: "memory"); __builtin_amdgcn_s_barrier(); asm volatile("" ::: "memory");
        return bad;
    }
};
struct EpiLnRes {
    static constexpr bool PERM = false, AFTER_DRAIN = true;
    const float* base; float* out; int ldc; const float* bias; PanelStats st; unsigned poison;
    __device__ __forceinline__ void fused(f32x4 (&acc)[2][2][4][2], const Unit& u, int wr, int wc, int fr, int fq, PG8_LAS unsigned char* lds, int wid, int lane) const {
        typedef float f32x2v __attribute__((ext_vector_type(2)));
        const PG8_LAS f32x2v* S = (const PG8_LAS f32x2v*)(lds + 8192);
        const int col0 = u.pn * BM + wc * 32 + 4 * fq;
#pragma unroll
        for (int bj = 0; bj < 2; ++bj)
#pragma unroll
            for (int n = 0; n < 2; ++n) { const f32x4 bv = bias ? *(const f32x4*)(bias + col0 + bj * HALF + n * 16) : (f32x4){0.f, 0.f, 0.f, 0.f};
#pragma unroll
                for (int ai = 0; ai < 2; ++ai)
#pragma unroll
                    for (int m = 0; m < 4; ++m) acc[ai][bj][m][n] += bv; }
        f32x4 pre[4][2][2];
#pragma unroll
        for (int m = 0; m < 4; ++m) { const size_t off = (size_t)(u.pm * BM + wr * 64 + m * 16 + fr) * ldc + col0;
#pragma unroll
            for (int bj = 0; bj < 2; ++bj)
#pragma unroll
                for (int n = 0; n < 2; ++n) pre[m][bj][n] = *(const f32x4*)(base + off + bj * HALF + n * 16); }
        const bool bad = st.run(acc, u, wr, wc, fr, fq, lds, wid, lane) || poison != 0u;
        const float qnan = __builtin_nanf("");
#pragma unroll
        for (int ai = 0; ai < 2; ++ai)
#pragma unroll
            for (int m = 0; m < 4; ++m) { const int r = ai * HALF + wr * 64 + m * 16 + fr; const f32x2v sr = S[r]; const size_t off = (size_t)(u.pm * BM + r) * ldc + col0;
#pragma unroll
                for (int bj = 0; bj < 2; ++bj)
#pragma unroll
                    for (int n = 0; n < 2; ++n) { const f32x4 bs = ai == 0 ? pre[m][bj][n] : *(const f32x4*)(base + off + bj * HALF + n * 16); f32x4 o = bs + (acc[ai][bj][m][n] - sr.x) * sr.y;
                        if (bad) o = (f32x4){qnan, qnan, qnan, qnan}; *(f32x4*)(out + off + bj * HALF + n * 16) = o; }
                if (m & 1) asm volatile("" ::: "memory"); }
    }
};
struct EpiLnResLn {
    static constexpr bool PERM = false, AFTER_DRAIN = true;
    const float* base; float* out; bf16_t* xn; int ldc; const float* bias; PanelStats st1, st2; unsigned poison;
    __device__ __forceinline__ void fused(f32x4 (&acc)[2][2][4][2], const Unit& u, int wr, int wc, int fr, int fq, PG8_LAS unsigned char* lds, int wid, int lane) const {
        typedef float f32x2v __attribute__((ext_vector_type(2))); typedef unsigned u32x2v __attribute__((ext_vector_type(2)));
        const PG8_LAS f32x2v* S = (const PG8_LAS f32x2v*)(lds + 8192);
        const int col0 = u.pn * BM + wc * 32 + 4 * fq;
#pragma unroll
        for (int bj = 0; bj < 2; ++bj)
#pragma unroll
            for (int n = 0; n < 2; ++n) { const f32x4 bv = bias ? *(const f32x4*)(bias + col0 + bj * HALF + n * 16) : (f32x4){0.f, 0.f, 0.f, 0.f};
#pragma unroll
                for (int ai = 0; ai < 2; ++ai)
#pragma unroll
                    for (int m = 0; m < 4; ++m) acc[ai][bj][m][n] += bv; }
        bool bad = st1.run(acc, u, wr, wc, fr, fq, lds, wid, lane) || poison != 0u;
        const float qnan = __builtin_nanf("");
#pragma unroll
        for (int ai = 0; ai < 2; ++ai)
#pragma unroll
            for (int m = 0; m < 4; ++m) { const int r = ai * HALF + wr * 64 + m * 16 + fr; const f32x2v sr = S[r]; const size_t off = (size_t)(u.pm * BM + r) * ldc + col0;
#pragma unroll
                for (int bj = 0; bj < 2; ++bj)
#pragma unroll
                    for (int n = 0; n < 2; ++n) { const f32x4 bs = *(const f32x4*)(base + off + bj * HALF + n * 16); acc[ai][bj][m][n] = bs + (acc[ai][bj][m][n] - sr.x) * sr.y; }
                asm volatile("" : "+v"(acc[ai][0][m][0]), "+v"(acc[ai][0][m][1]), "+v"(acc[ai][1][m][0]), "+v"(acc[ai][1][m][1]));
                if (m & 1) asm volatile("" ::: "memory"); }
        const bool bad1 = bad;
        bad = st2.run(acc, u, wr, wc, fr, fq, lds, wid, lane) || bad;
#pragma unroll
        for (int ai = 0; ai < 2; ++ai)
#pragma unroll
            for (int m = 0; m < 4; ++m) { const int r = ai * HALF + wr * 64 + m * 16 + fr; const f32x2v sr = S[r]; const size_t off = (size_t)(u.pm * BM + r) * ldc + col0;
#pragma unroll
                for (int bj = 0; bj < 2; ++bj)
#pragma unroll
                    for (int n = 0; n < 2; ++n) { const f32x4 x1 = acc[ai][bj][m][n]; *(f32x4*)(out + off + bj * HALF + n * 16) = bad1 ? (f32x4){qnan, qnan, qnan, qnan} : x1;
                        const f32x4 o = (x1 - sr.x) * sr.y; u32x2v w; w.x = cvt_pk_bf16(o[0], o[1]); w.y = cvt_pk_bf16(o[2], o[3]);
                        if (bad) { w.x = 0x7fc07fc0u; w.y = 0x7fc07fc0u; } *(u32x2v*)(xn + off + bj * HALF + n * 16) = w; }
                asm volatile("" ::: "memory"); }
    }
};

template <class Epi, class Sched, bool ALIGN_EPI = false, bool SP2 = false>
__device__ __forceinline__ void gemm_phase(PG8_LAS unsigned char* lds, const Gemm g, const Sched& S, const Epi& E) {
    const int tid = threadIdx.x, wid = __builtin_amdgcn_readfirstlane(tid >> 6), lane = tid & 63, wr = wid >> 2, wc = wid & 3, fr = lane & 15, fq = lane >> 4;
    const int K = g.K, nt = K / BK;
    unsigned voffA[2], voffB[2];
#pragma unroll
    for (int i = 0; i < 2; ++i) { int R, C; stage_rc(tid * 16 + i * 8192, R, C); const int Rb = Epi::PERM ? ((R & ~31) + perm32(R & 31)) : R;
        voffA[i] = (unsigned)(R * K + C) * 2u; voffB[i] = (unsigned)(Rb * K + C) * 2u; }
    const size_t kstep = (size_t)(BK * 2);
    const size_t hstep = (size_t)HALF * K * 2;
    const size_t tstep = 2 * hstep;
    const unsigned ldsw = (unsigned)wid * 1024u;
    const int aoff = lds_byte(wr * 64 + fr, fq * 8), boff = lds_byte(wc * 32 + fr, fq * 8);
#define PG8_SA(b, h) (((b) * 2 + (h)) * HTB)
#define PG8_SB(b, h) ((4 + (b) * 2 + (h)) * HTB)
#define PG8_STAGE(bufoff, gbase, voff) do { _Pragma("unroll") for (int _i = 0; _i < 2; ++_i) \
        __builtin_amdgcn_global_load_lds((const unsigned*)((const char*)(gbase) + (voff)[_i]), (PG8_LAS unsigned*)(lds + (bufoff) + ldsw + _i * 8192), 16, 0, 0); } while (0)
#define PG8_LDA(dst, b, h) do { _Pragma("unroll") for (int m = 0; m < 4; ++m) _Pragma("unroll") for (int k = 0; k < 2; ++k) dst[m][k] = *(const PG8_LAS bf16x8*)(lds + PG8_SA(b, h) + aoff + m * 2048 + k * 1024); } while (0)
#define PG8_LDB(dst, b, h) do { _Pragma("unroll") for (int n = 0; n < 2; ++n) _Pragma("unroll") for (int k = 0; k < 2; ++k) dst[n][k] = *(const PG8_LAS bf16x8*)(lds + PG8_SB(b, h) + boff + n * 2048 + k * 1024); } while (0)
#define PG8_MMA(ai, bj, At, Bt) do { __builtin_amdgcn_s_setprio(1); _Pragma("unroll") for (int m = 0; m < 4; ++m) _Pragma("unroll") for (int n = 0; n < 2; ++n) _Pragma("unroll") for (int k = 0; k < 2; ++k) \
        acc[ai][bj][m][n] = __builtin_amdgcn_mfma_f32_16x16x32_bf16(Bt[n][k], At[m][k], acc[ai][bj][m][n], 0, 0, 0); __builtin_amdgcn_s_setprio(0); } while (0)
#define PG8_WAIT_V(n) asm volatile("s_waitcnt vmcnt(" #n ")" ::: "memory")
#define PG8_WAIT_L(n) asm volatile("s_waitcnt lgkmcnt(" #n ")" ::: "memory")
#define PG8_BAR __builtin_amdgcn_s_barrier()
#define PG8_SCHED __builtin_amdgcn_sched_barrier(0)
    Unit cur, nxt; int ui = 0;
    if (!S.next(0, cur)) return;
    f32x4 acc[2][2][4][2];
#pragma unroll
    for (int a = 0; a < 2; ++a)
#pragma unroll
        for (int b = 0; b < 2; ++b)
#pragma unroll
            for (int m = 0; m < 4; ++m)
#pragma unroll
                for (int n = 0; n < 2; ++n) acc[a][b][m][n] = (f32x4){0.f, 0.f, 0.f, 0.f};
    bf16x8 At[4][2], B0[2][2], B1[2][2];
    const char* cA = (const char*)g.A + (size_t)cur.pm * tstep; const char* cB = (const char*)g.Bt + (size_t)cur.pn * tstep;
    S.a_ready(cur);
    if constexpr (SP2) {
        PG8_STAGE(PG8_SB(0, 0), cB, voffB); PG8_STAGE(PG8_SB(0, 1), cB + hstep, voffB); PG8_STAGE(PG8_SA(0, 0), cA, voffA); PG8_STAGE(PG8_SA(0, 1), cA + hstep, voffA);
        if (wr == 1) PG8_BAR;
        PG8_WAIT_V(2); PG8_BAR;
        PG8_STAGE(PG8_SB(1, 0), cB + kstep, voffB); PG8_STAGE(PG8_SA(1, 0), cA + kstep, voffA); PG8_STAGE(PG8_SB(1, 1), cB + hstep + kstep, voffB);
        PG8_WAIT_V(6); PG8_BAR;
    } else {
        PG8_STAGE(PG8_SB(0, 0), cB, voffB); PG8_STAGE(PG8_SA(0, 0), cA, voffA); PG8_STAGE(PG8_SB(0, 1), cB + hstep, voffB); PG8_STAGE(PG8_SA(0, 1), cA + hstep, voffA);
        if (wr == 1) PG8_BAR;
        PG8_WAIT_V(4); PG8_BAR;
        PG8_STAGE(PG8_SB(1, 0), cB + kstep, voffB); PG8_STAGE(PG8_SA(1, 0), cA + kstep, voffA); PG8_STAGE(PG8_SB(1, 1), cB + hstep + kstep, voffB);
        PG8_WAIT_V(6); PG8_BAR;
    }
    for (;;) {
        const bool has_next = S.next(ui + 1, nxt);
        const char* nA = has_next ? (const char*)g.A + (size_t)nxt.pm * tstep : cA; const char* nB = has_next ? (const char*)g.Bt + (size_t)nxt.pn * tstep : cB;
        for (int t = 0; t < nt; t += 2) {
            const bool last = (t == nt - 2);
            const char* a1 = cA + (size_t)(t + 1) * kstep;
            const char* a2 = last ? nA : cA + (size_t)(t + 2) * kstep; const char* b2 = last ? nB : cB + (size_t)(t + 2) * kstep;
            const char* a3 = a2 + kstep; const char* b3 = b2 + kstep;
            if (last && has_next) S.a_ready(nxt);
            if constexpr (SP2) {
            PG8_LDB(B0, 0, 0); PG8_LDB(B1, 0, 1); PG8_SCHED; PG8_LDA(At, 0, 0); PG8_STAGE(PG8_SA(1, 1), a1 + hstep, voffA);
            PG8_WAIT_V(8); PG8_WAIT_L(0); PG8_BAR; PG8_MMA(0, 0, At, B0); PG8_MMA(0, 1, At, B1); PG8_BAR; PG8_SCHED;
            PG8_LDA(At, 0, 1); PG8_STAGE(PG8_SB(0, 0), b2, voffB); PG8_STAGE(PG8_SB(0, 1), b2 + hstep, voffB); PG8_STAGE(PG8_SA(0, 0), a2, voffA);
            PG8_WAIT_V(8); PG8_WAIT_L(0); PG8_BAR; PG8_MMA(1, 0, At, B0); PG8_MMA(1, 1, At, B1); PG8_BAR; PG8_SCHED;
            PG8_LDB(B0, 1, 0); PG8_LDB(B1, 1, 1); PG8_SCHED; PG8_LDA(At, 1, 0); PG8_STAGE(PG8_SA(0, 1), a2 + hstep, voffA);
            PG8_WAIT_V(8); PG8_WAIT_L(0); PG8_BAR; PG8_MMA(0, 0, At, B0); PG8_MMA(0, 1, At, B1); PG8_BAR; PG8_SCHED;
            PG8_LDA(At, 1, 1); PG8_STAGE(PG8_SB(1, 0), b3, voffB); PG8_STAGE(PG8_SB(1, 1), b3 + hstep, voffB); PG8_STAGE(PG8_SA(1, 0), a3, voffA);
            PG8_WAIT_V(8); PG8_WAIT_L(0); PG8_BAR; PG8_MMA(1, 0, At, B0); PG8_MMA(1, 1, At, B1); PG8_BAR; PG8_SCHED;
            } else {
            PG8_LDB(B0, 0, 0); PG8_SCHED; PG8_LDA(At, 0, 0); PG8_STAGE(PG8_SA(1, 1), a1 + hstep, voffA);
            PG8_WAIT_L(8); PG8_BAR; PG8_WAIT_L(0); PG8_MMA(0, 0, At, B0); PG8_BAR; PG8_SCHED;
            PG8_LDB(B1, 0, 1); PG8_STAGE(PG8_SB(0, 0), b2, voffB);
            PG8_BAR; PG8_WAIT_L(0); PG8_MMA(0, 1, At, B1); PG8_BAR;
            PG8_LDA(At, 0, 1); PG8_STAGE(PG8_SA(0, 0), a2, voffA);
            PG8_BAR; PG8_WAIT_L(0); PG8_MMA(1, 0, At, B0); PG8_BAR; PG8_SCHED;
            PG8_STAGE(PG8_SB(0, 1), b2 + hstep, voffB);
            PG8_WAIT_V(6); PG8_BAR; PG8_MMA(1, 1, At, B1); PG8_BAR;
            PG8_LDB(B0, 1, 0); PG8_SCHED; PG8_LDA(At, 1, 0); PG8_STAGE(PG8_SA(0, 1), a2 + hstep, voffA);
            PG8_WAIT_L(8); PG8_BAR; PG8_WAIT_L(0); PG8_MMA(0, 0, At, B0); PG8_BAR; PG8_SCHED;
            PG8_LDB(B1, 1, 1); PG8_STAGE(PG8_SB(1, 0), b3, voffB);
            PG8_BAR; PG8_WAIT_L(0); PG8_MMA(0, 1, At, B1); PG8_BAR;
            PG8_LDA(At, 1, 1); PG8_STAGE(PG8_SA(1, 0), a3, voffA);
            PG8_BAR; PG8_WAIT_L(0); PG8_MMA(1, 0, At, B0); PG8_BAR; PG8_SCHED;
            PG8_STAGE(PG8_SB(1, 1), b3 + hstep, voffB);
            PG8_WAIT_V(6); PG8_BAR; PG8_MMA(1, 1, At, B1); PG8_BAR;
            }
        }
        if constexpr (ALIGN_EPI) { if (wr == 0) PG8_BAR; }
        if constexpr (!Epi::AFTER_DRAIN) { E(acc, cur, wr, wc, fr, fq); S.done(cur); }
        if (!has_next) break;
#pragma unroll
        for (int a = 0; a < 2; ++a)
#pragma unroll
            for (int b = 0; b < 2; ++b)
#pragma unroll
                for (int m = 0; m < 4; ++m)
#pragma unroll
                    for (int n = 0; n < 2; ++n) acc[a][b][m][n] = (f32x4){0.f, 0.f, 0.f, 0.f};
        cur = nxt; cA = nA; cB = nB; ++ui;
        if constexpr (ALIGN_EPI) { if (wr == 1) PG8_BAR; }
    }
    PG8_WAIT_V(0);
    if constexpr (!ALIGN_EPI) { if (wr == 0) PG8_BAR; }
    PG8_BAR;
    if constexpr (Epi::AFTER_DRAIN) { E.fused(acc, cur, wr, wc, fr, fq, lds, wid, lane); S.done(cur); }
#undef PG8_SA
#undef PG8_SB
#undef PG8_STAGE
#undef PG8_LDA
#undef PG8_LDB
#undef PG8_MMA
#undef PG8_WAIT_V
#undef PG8_WAIT_L
#undef PG8_BAR
#undef PG8_SCHED
}
}
#define GAS __attribute__((address_space(1)))
#define LAS __attribute__((address_space(3)))
typedef unsigned short bf16;
typedef unsigned v4u __attribute__((ext_vector_type(4)));
typedef float f32x4 __attribute__((ext_vector_type(4)));
typedef short bf16x8 __attribute__((ext_vector_type(8)));
typedef GAS unsigned gu32;
typedef GAS unsigned long long gu64;
#define RLX_AGENT __ATOMIC_RELAXED, __HIP_MEMORY_SCOPE_AGENT
#define LDS_WAIT() asm volatile("s_waitcnt lgkmcnt(0)" ::: "memory")
#define VM_WAIT() asm volatile("s_waitcnt vmcnt(0)" ::: "memory")
__device__ __forceinline__ unsigned long long rt() { return __builtin_amdgcn_s_memrealtime(); }
__device__ __forceinline__ unsigned f2bf(float f) { unsigned u = __builtin_bit_cast(unsigned, f); return (u + 0x7fffu + ((u >> 16) & 1u)) >> 16; }
__device__ __forceinline__ unsigned pk2(float lo, float hi) { return f2bf(lo) | (f2bf(hi) << 16); }

#define XB_TMO      128
#define XB_XCNT(j)  (256  + 64 * (j))
#define XB_XSUB(j)  (1280 + 64 * (j))
#define XB_XGEN(j)  (2304 + 64 * (j))
#define XB_TOP      3328
#define XB_TOPGEN   3392
#define XCD_BAR_WORDS 3456
#define XB_SPIN_CAP (1u << 22)

__device__ __forceinline__ unsigned xb_ld(unsigned* p)              { return __hip_atomic_load(p, __ATOMIC_RELAXED, __HIP_MEMORY_SCOPE_AGENT); }
__device__ __forceinline__ unsigned xb_add(unsigned* p, unsigned v) { return __hip_atomic_fetch_add(p, v, __ATOMIC_RELAXED, __HIP_MEMORY_SCOPE_AGENT); }
__device__ __forceinline__ unsigned xb_xcc_id() { return (unsigned)__builtin_amdgcn_s_getreg((3 << 11) | 20) & 0xFu; }
#define XB_SPIN(cond, bar) do { unsigned _sp = 0; while (cond) { __builtin_amdgcn_s_sleep(1); \
    if ((++_sp & 255u) == 0u) { if (xb_ld(&(bar)[XB_TMO])) break; if (_sp > XB_SPIN_CAP) { atomicAdd(&(bar)[XB_TMO], 1u); break; } } } } while (0)

struct XcdBarrier {
    unsigned* bar; unsigned x;
    volatile LAS unsigned* st;
};

__device__ __forceinline__ XcdBarrier xcd_barrier_post(unsigned* bar, volatile LAS unsigned* st) {
    XcdBarrier b; b.bar = bar; b.x = xb_xcc_id(); b.st = st;
    if (threadIdx.x == 0) (void)xb_add(&bar[XB_XCNT(b.x)], 1u);
    return b;
}
__device__ __forceinline__ void xcd_barrier_complete(unsigned* bar, unsigned x, unsigned& nloc, unsigned& nx) {
    const unsigned G = gridDim.x * gridDim.y * gridDim.z;
    unsigned sum, cnt, mine, sp = 0u;
    for (;;) {
        sum = 0u; cnt = 0u; mine = 0u;
#pragma unroll
        for (unsigned j = 0; j < 16; ++j) { const unsigned c = xb_ld(&bar[XB_XCNT(j)]); sum += c; cnt += (c > 0u) ? 1u : 0u; mine = (j == x) ? c : mine; }
        if (sum == G) break;
        __builtin_amdgcn_s_sleep(1);
        if ((++sp & 255u) == 0u) { if (xb_ld(&bar[XB_TMO])) break; if (sp > XB_SPIN_CAP) { atomicAdd(&bar[XB_TMO], 1u); break; } }
    }
    nloc = mine > 0u ? mine : 1u; nx = cnt > 0u ? cnt : 1u;
}

__device__ __forceinline__ void xcd_barrier(const XcdBarrier& b) {
    asm volatile("s_waitcnt vmcnt(0)" ::: "memory");
    __syncthreads();
    if (threadIdx.x == 0) {
        unsigned* bar = b.bar;
        __builtin_amdgcn_s_waitcnt(0);
        unsigned nloc = b.st[0], nx = b.st[1];
        if (nloc == 0u) { xcd_barrier_complete(bar, b.x, nloc, nx); b.st[0] = nloc; b.st[1] = nx; }
        const unsigned old = xb_add(&bar[XB_XSUB(b.x)], 1u);
        const unsigned gen = old / nloc;
        if (old + 1u == (gen + 1u) * nloc) {
            __builtin_amdgcn_fence(__ATOMIC_RELEASE, "agent");
            asm volatile("s_waitcnt vmcnt(0)" ::: "memory");
            const unsigned og = xb_add(&bar[XB_TOP], 1u);
            const unsigned tg = og / nx;
            if (og + 1u == (tg + 1u) * nx) xb_add(&bar[XB_TOPGEN], 1u);
            else XB_SPIN(xb_ld(&bar[XB_TOPGEN]) == tg, bar);
            __builtin_amdgcn_fence(__ATOMIC_ACQUIRE, "agent");
            xb_add(&bar[XB_XGEN(b.x)], 1u);
            asm volatile("s_waitcnt vmcnt(0)" ::: "memory");
        } else {
            XB_SPIN(xb_ld(&bar[XB_XGEN(b.x)]) == gen, bar);
            __builtin_amdgcn_fence(__ATOMIC_ACQUIRE, "agent");
            asm volatile("s_waitcnt vmcnt(0)" ::: "memory");
        }
    }
    __syncthreads();
}

namespace fox {
using bf16 = __hip_bfloat16;
using bf16x8 = __attribute__((ext_vector_type(8))) short;
using s16x4 = __attribute__((ext_vector_type(4))) short;
using f32x16 = __attribute__((ext_vector_type(16))) float;
using u32x4 = __attribute__((ext_vector_type(4))) unsigned;
using f32x4v = __attribute__((ext_vector_type(4))) float;
constexpr int BATCH = 16, NHEAD = 8, SEQ = 2048, D = 64, DM = NHEAD * D;
constexpr int NW = 8, QBLK = 32, QB = QBLK * NW, KVBLK = 64, NQB = SEQ / QB;
constexpr float C2 = 0.125f * 1.4426950408889634f;
constexpr int SLOTB = 8192, LDS_K = 0, LDS_V = 3 * SLOTB, LDS_WS = 6 * SLOTB, LDS_OST = LDS_WS + NW * 256, LDS_CB = LDS_OST + NW * 4096, LDS_BYTES = LDS_CB + SEQ * 4;
#define SBAR() __builtin_amdgcn_sched_barrier(0)
#define PIN(x) asm volatile("" : "+v"(x))
#define MFMA(a, b, c) __builtin_amdgcn_mfma_f32_32x32x16_bf16(a, b, c, 0, 0, 0)
#define WAIT_BAR(N) asm volatile("s_waitcnt vmcnt(" #N ") lgkmcnt(0)\n\ts_barrier" ::: "memory")

__device__ __forceinline__ int crow(int r, int hi) { return (r & 3) + 8 * (r >> 2) + 4 * hi; }
__device__ __forceinline__ unsigned cvtpk(float lo, float hi) { unsigned r; asm("v_cvt_pk_bf16_f32 %0, %1, %2" : "=v"(r) : "v"(lo), "v"(hi)); return r; }
__device__ __forceinline__ void glds16(const void* g, unsigned lds_base) {
    unsigned sv; asm volatile("s_mov_b32 %0, m0\n\ts_mov_b32 m0, %2\n\ts_nop 0\n\tglobal_load_lds_dwordx4 %1, off\n\ts_mov_b32 m0, %0" : "=&s"(sv) : "v"(g), "s"(lds_base) : "memory"); }
typedef __attribute__((address_space(3))) const char* lds_cptr;
typedef short v4i16_t __attribute__((ext_vector_type(4)));
__device__ __forceinline__ void kload2(bf16x8* kf, lds_cptr kp, int d0) { kf[2 * d0] = *(const __attribute__((address_space(3))) bf16x8*)(kp + d0 * 2048); kf[2 * d0 + 1] = *(const __attribute__((address_space(3))) bf16x8*)(kp + d0 * 2048 + 512); }
__device__ __forceinline__ s16x4 vtr(lds_cptr p) { return __builtin_bit_cast(s16x4, __builtin_amdgcn_ds_read_tr16_b64_v4i16((__attribute__((address_space(3))) v4i16_t*)p)); }
#define MX3(a, b, c) __builtin_fmaxf(__builtin_fmaxf((a), (b)), (c))
__device__ __forceinline__ float rowmax(const f32x16& p0, const f32x16& p1) {
    float a = MX3(p0[0], p0[1], p1[0]), b = MX3(p0[2], p0[3], p1[1]); a = MX3(a, p1[2], p1[3]);
#pragma unroll
    for (int r = 4; r < 16; r += 4) { a = MX3(a, p0[r], p0[r + 1]); b = MX3(b, p0[r + 2], p0[r + 3]); a = MX3(a, p1[r], p1[r + 1]); b = MX3(b, p1[r + 2], p1[r + 3]); }
    float m = __builtin_fmaxf(a, b); auto rr = __builtin_amdgcn_permlane32_swap(__float_as_uint(m), __float_as_uint(m), false, false);
    return __builtin_fmaxf(__uint_as_float(rr[0]), __uint_as_float(rr[1])); }
__device__ __forceinline__ void cmask(f32x16& p0, f32x16& p1, int jb, int qrel, int hi) {
    const int kb = 64 * jb + 4 * hi;
#pragma unroll
    for (int r = 0; r < 16; ++r) { const int kv = kb + (r & 3) + 8 * (r >> 2); if (kv > qrel) p0[r] = -INFINITY; if (kv + 32 > qrel) p1[r] = -INFINITY; } }

__device__ __forceinline__ void attn64_unit(int b, int h, int qb, const bf16* Q, const bf16* __restrict__ K, const bf16* __restrict__ V, bf16* O, const float* __restrict__ CBg, char* lds) {
    const int tid = threadIdx.x, lane = tid & 63, r32 = lane & 31, hi = lane >> 5; const int wid = __builtin_amdgcn_readfirstlane(tid >> 6);
    const long rowbase = (long)b * SEQ; const int q0 = qb * QB, NT = (q0 + QB) / KVBLK;
    const bf16* Qw = Q + (rowbase + q0 + wid * QBLK) * DM + h * D;
    const unsigned lds0 = (unsigned)(uintptr_t)lds; float* wsf = (float*)(lds + LDS_WS) + wid * 64;
    const bf16* ksrc = K + rowbase * DM + h * D + (long)lane * DM + wid * 8;
    const bf16* vsrc = V + rowbase * DM + h * D + (long)(16 * (wid & 3) + (lane >> 2)) * DM + (wid >> 2) * 32 + (lane & 3) * 8;
    const unsigned kdst = lds0 + LDS_K + wid * 1024, vdst = lds0 + LDS_V + wid * 1024;
#define DMA_K(t, slot) glds16(ksrc + (long)(t) * KVBLK * DM, (unsigned)__builtin_amdgcn_readfirstlane(kdst + (slot)))
#define DMA_V(t, slot) glds16(vsrc + (long)(t) * KVBLK * DM, (unsigned)__builtin_amdgcn_readfirstlane(vdst + (slot)))
    const lds_cptr vp0 = (lds_cptr)lds + LDS_V + ((lane >> 4) & 1) * 32 + (lane & 3) * 8 + (4 * hi + ((lane & 15) >> 2)) * 64;
    const lds_cptr kp0 = (lds_cptr)lds + LDS_K + hi * 1024 + r32 * 16;
    const bool cb_mine = (4 * tid < NT * KVBLK); f32x4v cbv = (f32x4v){0.f, 0.f, 0.f, 0.f};
    if (cb_mine) cbv = *(const f32x4v*)(CBg + (long)(b * NHEAD + h) * SEQ + 4 * tid);
    DMA_K(0, 0); DMA_V(0, 0); DMA_K(1, SLOTB);
    bf16x8 qr[4];
#pragma unroll
    for (int d0 = 0; d0 < 4; ++d0) qr[d0] = *reinterpret_cast<const bf16x8*>(&Qw[(long)r32 * DM + d0 * 16 + hi * 8]);
    float mhat = 0.f, l_reg = 0.f; f32x16 o[2]; o[0] = f32x16{}; o[1] = f32x16{};
    const lds_cptr cbp0 = (lds_cptr)lds + LDS_CB + hi * 16;
#define LDBIAS(P0_, P1_, t_) do { const lds_cptr cq_ = cbp0 + (t_) * 256; _Pragma("unroll") for (int g_ = 0; g_ < 4; ++g_) { \
        const f32x4v a_ = *(const __attribute__((address_space(3))) f32x4v*)(cq_ + g_ * 32), b_ = *(const __attribute__((address_space(3))) f32x4v*)(cq_ + 128 + g_ * 32); \
        P0_[4 * g_] = a_[0]; P0_[4 * g_ + 1] = a_[1]; P0_[4 * g_ + 2] = a_[2]; P0_[4 * g_ + 3] = a_[3]; P1_[4 * g_] = b_[0]; P1_[4 * g_ + 1] = b_[1]; P1_[4 * g_ + 2] = b_[2]; P1_[4 * g_ + 3] = b_[3]; } } while (0)
#define LDBIAS2(G_, P0_, P1_, t_, g_) do { if (G_) { const lds_cptr cq_ = cbp0 + (t_) * 256; \
        const f32x4v a_ = *(const __attribute__((address_space(3))) f32x4v*)(cq_ + (g_) * 32), b_ = *(const __attribute__((address_space(3))) f32x4v*)(cq_ + 128 + (g_) * 32); \
        P0_[4 * (g_)] = a_[0]; P0_[4 * (g_) + 1] = a_[1]; P0_[4 * (g_) + 2] = a_[2]; P0_[4 * (g_) + 3] = a_[3]; P1_[4 * (g_)] = b_[0]; P1_[4 * (g_) + 1] = b_[1]; P1_[4 * (g_) + 2] = b_[2]; P1_[4 * (g_) + 3] = b_[3]; SBAR(); } } while (0)
    const int qrel = wid * QBLK + r32; bool resc = false;
    f32x16 pA0, pA1, pB0, pB1; bf16x8 kf[8]; s16x4 vlo[8], vhi[8]; u32x4 pw0, pw1, pw2, pw3;
    int sl_prev = 0, sl_cur = 0, sl_next = SLOTB;
#define ROT() do { sl_prev = sl_cur; sl_cur = sl_next; sl_next = (sl_next == 2 * SLOTB) ? 0 : sl_next + SLOTB; } while (0)
#define EX(v) __builtin_amdgcn_exp2f(__builtin_fmaf((v), C2, nmh))
#define RESC() do { if (resc) { _Pragma("unroll") for (int d_ = 0; d_ < 2; ++d_) _Pragma("unroll") for (int r = 0; r < 16; ++r) o[d_][r] *= wsf[crow(r, hi)]; } } while (0)
    DMA_K(2, 2 * SLOTB);
    if (cb_mine) *(__attribute__((address_space(3))) f32x4v*)((lds_cptr)lds + LDS_CB + 16 * tid) = cbv;
    WAIT_BAR(3);
    _Pragma("unroll") for (int d0 = 0; d0 < 4; ++d0) kload2(kf, kp0, d0);
    LDBIAS(pA0, pA1, 0);
    pA0 = MFMA(kf[0], qr[0], pA0); pA1 = MFMA(kf[1], qr[0], pA1); pA0 = MFMA(kf[2], qr[1], pA0); pA1 = MFMA(kf[3], qr[1], pA1);
    pA0 = MFMA(kf[4], qr[2], pA0); pA1 = MFMA(kf[5], qr[2], pA1); pA0 = MFMA(kf[6], qr[3], pA0); pA1 = MFMA(kf[7], qr[3], pA1);
    if (NT == 4) cmask(pA0, pA1, 0, qrel, hi);
    { const float rm = rowmax(pA0, pA1); mhat = rm * C2; const float nmh = -mhat;
#pragma unroll
      for (int r = 0; r < 16; ++r) { pA0[r] = EX(pA0[r]); pA1[r] = EX(pA1[r]); } }
    WAIT_BAR(0);
    DMA_K(3, 0); DMA_V(1, SLOTB); ROT();
    _Pragma("unroll") for (int d0 = 0; d0 < 4; ++d0) kload2(kf, kp0 + sl_cur, d0);
    LDBIAS(pB0, pB1, 1);
    WAIT_BAR(2);
#define PKW(P, i) cvtpk(P[i], P[i + 1])
#define PAF(k) __builtin_bit_cast(bf16x8, pw##k)
#define VFR(i) (bf16x8){vlo[i][0], vlo[i][1], vlo[i][2], vlo[i][3], vhi[i][0], vhi[i][1], vhi[i][2], vhi[i][3]}
#define VRD(i) do { vlo[i] = vtr(vp_ + (((i) >> 2) * 4096 + ((i) & 3) * 1024)); vhi[i] = vtr(vp_ + (((i) >> 2) * 4096 + ((i) & 3) * 1024 + 512)); } while (0)
#define KRD(G, d0) do { if (G) { kload2(kf, kp0 + sl_next, d0); SBAR(); } } while (0)
#define GAPA(MF, a0, a1, a2, a3, W0, W1, PW) do { MF; sacc += a0; sacc += a1; sacc += a2; sacc += a3; W0; W1; PIN(PW); PIN(sacc); SBAR(); } while (0)
#define GAPB(MF, X, i) do { MF; X[i] = EX(X[i]); X[i + 1] = EX(X[i + 1]); X[i + 2] = EX(X[i + 2]); X[i + 3] = EX(X[i + 3]); PIN(X); SBAR(); } while (0)
#define STEP(C0, C1, P0, P1, t, MASK, GK, GV, GL) do { SBAR(); \
    const lds_cptr vp_ = vp0 + sl_prev; \
    VRD(0); SBAR(); float sacc = P0[0] + P0[1];                                                                                                       \
                    GAPA(C0 = MFMA(kf[0], qr[0], C0), P0[2], P0[3], P0[4], P0[5],     pw0[0] = PKW(P0, 0),  pw0[1] = PKW(P0, 2),  pw0); \
    VRD(4); SBAR(); GAPA(C1 = MFMA(kf[1], qr[0], C1), P0[6], P0[7], P0[8], P0[9],     pw0[2] = PKW(P0, 4),  pw0[3] = PKW(P0, 6),  pw0); \
    VRD(1); SBAR(); GAPA(C0 = MFMA(kf[2], qr[1], C0),    P0[10], P0[11], P0[12], P0[13], pw1[0] = PKW(P0, 8),  pw1[1] = PKW(P0, 10), pw1); \
    VRD(5); SBAR(); GAPA(C1 = MFMA(kf[3], qr[1], C1),    P0[14], P0[15], P1[0], P1[1],   pw1[2] = PKW(P0, 12), pw1[3] = PKW(P0, 14), pw1); \
    VRD(2); SBAR(); GAPA(C0 = MFMA(kf[4], qr[2], C0),    P1[2], P1[3], P1[4], P1[5],     pw2[0] = PKW(P1, 0),  pw2[1] = PKW(P1, 2),  pw2); \
    VRD(6); SBAR(); GAPA(C1 = MFMA(kf[5], qr[2], C1),    P1[6], P1[7], P1[8], P1[9],     pw2[2] = PKW(P1, 4),  pw2[3] = PKW(P1, 6),  pw2); \
    VRD(3); SBAR(); GAPA(C0 = MFMA(kf[6], qr[3], C0),    P1[10], P1[11], P1[12], P1[13], pw3[0] = PKW(P1, 8),  pw3[1] = PKW(P1, 10), pw3); \
    VRD(7); SBAR(); GAPA(C1 = MFMA(kf[7], qr[3], C1),    P1[14], P1[15], 0.f, 0.f,       pw3[2] = PKW(P1, 12), pw3[3] = PKW(P1, 14), pw3); \
    l_reg += sacc; \
    if (GK) DMA_K((t) + 3, sl_cur); if (GV) DMA_V((t) + 1, sl_next);                                                       \
    if (MASK) cmask(C0, C1, (t) - (NT - 4), qrel, hi); \
    { const float rm = __builtin_fmaf(rowmax(C0, C1), C2, -mhat); resc = false;                                            \
      if (__builtin_expect(__any(rm > 8.0f), 0)) { const float dl = __builtin_fmaxf(rm, 0.f); mhat += dl;     \
          const float f = __builtin_amdgcn_exp2f(-dl); l_reg *= f; if (hi == 0) wsf[r32] = f; resc = true; } } \
    const float nmh = -mhat; SBAR(); \
    LDBIAS2(GL, P0, P1, (t) + 1, 0); GAPB(o[0] = MFMA(PAF(0), VFR(0), o[0]), C0, 0);   LDBIAS2(GL, P0, P1, (t) + 1, 1); GAPB(o[1] = MFMA(PAF(0), VFR(4), o[1]), C0, 4); \
    KRD(GL, 0); GAPB(o[0] = MFMA(PAF(1), VFR(1), o[0]), C0, 8);  KRD(GL, 1); GAPB(o[1] = MFMA(PAF(1), VFR(5), o[1]), C0, 12);                                     \
    KRD(GL, 2); GAPB(o[0] = MFMA(PAF(2), VFR(2), o[0]), C1, 0);  KRD(GL, 3); GAPB(o[1] = MFMA(PAF(2), VFR(6), o[1]), C1, 4); \
    LDBIAS2(GL, P0, P1, (t) + 1, 2); GAPB(o[0] = MFMA(PAF(3), VFR(3), o[0]), C1, 8);   LDBIAS2(GL, P0, P1, (t) + 1, 3); GAPB(o[1] = MFMA(PAF(3), VFR(7), o[1]), C1, 12); \
    } while (0)
    int t = 1;
    for (; t + 5 < NT; t += 2) {
        STEP(pB0, pB1, pA0, pA1, t, false, true, true, true);     WAIT_BAR(2); RESC(); ROT();
        STEP(pA0, pA1, pB0, pB1, t + 1, false, true, true, true); WAIT_BAR(2); RESC(); ROT();
    }
#define ENDW(tt) do { if ((tt) + 3 < NT) { WAIT_BAR(2); } else if ((tt) + 2 < NT) { WAIT_BAR(1); } else { WAIT_BAR(0); } } while (0)
    for (; t + 1 < NT; t += 2) {
        STEP(pB0, pB1, pA0, pA1, t, true, (t + 3 < NT), (t + 1 < NT), (t + 1 < NT));         ENDW(t);     RESC(); ROT();
        STEP(pA0, pA1, pB0, pB1, t + 1, true, (t + 4 < NT), (t + 2 < NT), (t + 2 < NT));     ENDW(t + 1); RESC(); ROT();
    }
    STEP(pB0, pB1, pA0, pA1, NT - 1, true, false, false, false); RESC();
    { float sacc = pB0[0] + pB0[1];
#pragma unroll
      for (int r = 2; r < 16; ++r) sacc += pB0[r];
#pragma unroll
      for (int r = 0; r < 16; ++r) sacc += pB1[r];
      l_reg += sacc;
      pw0 = (u32x4){PKW(pB0, 0), PKW(pB0, 2), PKW(pB0, 4), PKW(pB0, 6)}; pw1 = (u32x4){PKW(pB0, 8), PKW(pB0, 10), PKW(pB0, 12), PKW(pB0, 14)};
      pw2 = (u32x4){PKW(pB1, 0), PKW(pB1, 2), PKW(pB1, 4), PKW(pB1, 6)}; pw3 = (u32x4){PKW(pB1, 8), PKW(pB1, 10), PKW(pB1, 12), PKW(pB1, 14)};
      const lds_cptr vp_ = vp0 + sl_cur; _Pragma("unroll") for (int i = 0; i < 8; ++i) VRD(i);
      o[0] = MFMA(PAF(0), VFR(0), o[0]); o[1] = MFMA(PAF(0), VFR(4), o[1]); o[0] = MFMA(PAF(1), VFR(1), o[0]); o[1] = MFMA(PAF(1), VFR(5), o[1]);
      o[0] = MFMA(PAF(2), VFR(2), o[0]); o[1] = MFMA(PAF(2), VFR(6), o[1]); o[0] = MFMA(PAF(3), VFR(3), o[0]); o[1] = MFMA(PAF(3), VFR(7), o[1]); }
    { auto rr = __builtin_amdgcn_permlane32_swap(__float_as_uint(l_reg), __float_as_uint(l_reg), false, false); l_reg = __uint_as_float(rr[0]) + __uint_as_float(rr[1]); }
    if (hi == 0) wsf[32 + r32] = l_reg; asm volatile("s_waitcnt lgkmcnt(0)" ::: "memory");
    float rli[16];
#pragma unroll
    for (int r = 0; r < 16; ++r) rli[r] = __builtin_amdgcn_rcpf(wsf[32 + crow(r, hi)]);
    bf16* Ow = O + (rowbase + q0 + wid * QBLK) * DM + h * D; bf16* stg = (bf16*)(lds + LDS_OST) + wid * 2048;
#pragma unroll
    for (int r = 0; r < 16; ++r) { const int orow = crow(r, hi);
#pragma unroll
        for (int d0 = 0; d0 < 2; ++d0) stg[orow * 64 + d0 * 32 + r32] = __float2bfloat16(o[d0][r] * rli[r]); }
    asm volatile("s_waitcnt lgkmcnt(0)" ::: "memory");
#pragma unroll
    for (int i = 0; i < 4; ++i) { const int row = i * 8 + (lane >> 3), ch = lane & 7; *(u32x4*)(Ow + (long)row * DM + ch * 8) = *(const u32x4*)(stg + row * 64 + ch * 8); }
    asm volatile("s_waitcnt lgkmcnt(0)\n\ts_barrier" ::: "memory");
#undef DMA_K
#undef DMA_V
#undef ROT
#undef EX
#undef RESC
#undef PKW
#undef PAF
#undef VFR
#undef VRD
#undef KRD
#undef ENDW
#undef GAPA
#undef GAPB
#undef STEP
#undef LDBIAS
#undef LDBIAS2
}

#undef SBAR
#undef PIN
#undef MFMA
#undef WAIT_BAR
#undef MX3
}
constexpr int NWAVES = 8;
#ifndef MK_N_LAUNCHES
#define MK_N_LAUNCHES 1
#endif
constexpr int N_PHASES = 11;
constexpr int Bn = 16, Sn = 2048, Dm = 1024, T = Bn * Sn;
constexpr int NPROJ = 6656;
constexpr float ALPHA = 1.189207115002721f;
constexpr float LN_EPS = 1e-5f;
constexpr float GLA_EPS2 = 1e-5f * 128.0f;

constexpr size_t MiB = 1u << 20;
constexpr size_t WS_CTL = 0, CTL_ZERO_BYTES = 1 * MiB;
constexpr size_t WS_WIN = 1 * MiB;
constexpr size_t WS_WOF = 14 * MiB;
constexpr size_t WS_WOG = 15 * MiB;
constexpr size_t WS_WO  = 17 * MiB;
constexpr size_t WS_WQ  = 19 * MiB;
constexpr size_t WS_SK  = 23 * MiB;
constexpr size_t WS_EU  = 24 * MiB;
constexpr size_t WS_EV  = 56 * MiB;
constexpr size_t WS_FF  = 88 * MiB;
constexpr size_t WS_GLR = 89 * MiB;
constexpr size_t WS_CB  = 91 * MiB;
constexpr size_t WS_XB  = 92 * MiB;
constexpr size_t WS_FQ  = 156 * MiB;
constexpr size_t WS_FK  = 188 * MiB, WS_FV = 220 * MiB, WS_GQ = 252 * MiB, WS_GK = 284 * MiB;
constexpr size_t WS_GV  = 316 * MiB;
constexpr size_t WS_GG  = 380 * MiB;
constexpr size_t WS_IDX = 444 * MiB;
constexpr size_t WS_GATE = 452 * MiB;
constexpr size_t WS_END = 468 * MiB;
constexpr size_t WS_Y = WS_FQ, WS_QP = WS_GV;
constexpr int CW_TMO = 0, CW_BAR = 4096;

constexpr int RING_BYTES = 131072;
constexpr int LDSCTL_OFF = 160 * 1024 - 512, MISC_OFF = LDSCTL_OFF + 320;
constexpr int LDS_BYTES = 160 * 1024;

typedef unsigned long long u64;
typedef unsigned v2u __attribute__((ext_vector_type(2)));
typedef float f32x16 __attribute__((ext_vector_type(16)));
typedef short s16x4v __attribute__((ext_vector_type(4)));
typedef __bf16 bf16x2_t __attribute__((ext_vector_type(2)));

__device__ __forceinline__ float bf_lo(unsigned u) { return __builtin_bit_cast(float, u << 16); }
__device__ __forceinline__ float bf_hi(unsigned u) { return __builtin_bit_cast(float, u & 0xffff0000u); }
__device__ __forceinline__ float sigmoidf_(float x) { return __builtin_amdgcn_rcpf(1.0f + __expf(-x)); }
__device__ __forceinline__ float wave_sum(float v) {
#pragma unroll
    for (int o = 1; o < 64; o <<= 1) v += __shfl_xor(v, o);
    return v;
}
__device__ __forceinline__ float gelu_erf(float v) { return 0.5f * v * (1.0f + erff(v * 0.70710678118654752f)); }

namespace pg8 {
struct EpiProj {
    static constexpr bool PERM = true, AFTER_DRAIN = false;
    unsigned char* ws; unsigned char* dout;
    __device__ __forceinline__ void operator()(const f32x4 (&acc)[2][2][4][2], const Unit& u, int wr, int wc, int fr, int fq) const {
        const int pn = u.pn; bf16_t* base; int ldc, colt;
        if (pn < 10)      { base = (bf16_t*)(ws + WS_FQ + (size_t)(pn >> 1) * (32 * MiB)); ldc = 512; colt = (pn & 1) * 256; }
        else if (pn < 18) { base = (bf16_t*)(ws + WS_GV + (size_t)((pn - 10) >> 2) * (64 * MiB)); ldc = 1024; colt = ((pn - 10) & 3) * 256; }
        else              { base = (bf16_t*)(dout + (size_t)((pn - 18) >> 2) * (64 * MiB)); ldc = 1024; colt = ((pn - 18) & 3) * 256; }
        const int row0 = u.pm * BM + wr * 64 + fr, col0 = colt + wc * 32 + 8 * fq;
#pragma unroll
        for (int ai = 0; ai < 2; ++ai)
#pragma unroll
            for (int m = 0; m < 4; ++m) { bf16_t* rowp = base + (size_t)(row0 + ai * HALF + m * 16) * ldc + col0;
#pragma unroll
                for (int bj = 0; bj < 2; ++bj) { const f32x4 v0 = acc[ai][bj][m][0], v1 = acc[ai][bj][m][1];
                    u32x4 w; w.x = cvt_pk_bf16(v0[0], v0[1]); w.y = cvt_pk_bf16(v0[2], v0[3]); w.z = cvt_pk_bf16(v1[0], v1[1]); w.w = cvt_pk_bf16(v1[2], v1[3]);
                    *(u32x4*)(rowp + bj * HALF) = w; } }
    }
};
template <int MODE> struct EpiGate {
    static constexpr bool PERM = true, AFTER_DRAIN = false;
    const bf16_t* G; bf16_t* O;
    __device__ __forceinline__ void operator()(const f32x4 (&acc)[2][2][4][2], const Unit& u, int wr, int wc, int fr, int fq) const {
        const int row0 = u.pm * BM + wr * 64 + fr, col0 = u.pn * BM + wc * 32 + 8 * fq;
#pragma unroll
        for (int ai = 0; ai < 2; ++ai)
#pragma unroll
            for (int m = 0; m < 4; ++m) { const size_t off = (size_t)(row0 + ai * HALF + m * 16) * 1024 + col0;
#pragma unroll
                for (int bj = 0; bj < 2; ++bj) { const f32x4 v0 = acc[ai][bj][m][0], v1 = acc[ai][bj][m][1];
                    const u32x4 g = *(const u32x4*)(G + off + bj * HALF);
                    float r[8];
                    r[0] = v0[0] * sigmoidf_(bf_lo(g.x)); r[1] = v0[1] * sigmoidf_(bf_hi(g.x)); r[2] = v0[2] * sigmoidf_(bf_lo(g.y)); r[3] = v0[3] * sigmoidf_(bf_hi(g.y));
                    r[4] = v1[0] * sigmoidf_(bf_lo(g.z)); r[5] = v1[1] * sigmoidf_(bf_hi(g.z)); r[6] = v1[2] * sigmoidf_(bf_lo(g.w)); r[7] = v1[3] * sigmoidf_(bf_hi(g.w));
                    if (MODE == 1) { const u32x4 o = *(const u32x4*)(O + off + bj * HALF);
                        r[0] += bf_lo(o.x); r[1] += bf_hi(o.x); r[2] += bf_lo(o.y); r[3] += bf_hi(o.y); r[4] += bf_lo(o.z); r[5] += bf_hi(o.z); r[6] += bf_lo(o.w); r[7] += bf_hi(o.w); }
                    u32x4 w; w.x = cvt_pk_bf16(r[0], r[1]); w.y = cvt_pk_bf16(r[2], r[3]); w.z = cvt_pk_bf16(r[4], r[5]); w.w = cvt_pk_bf16(r[6], r[7]);
                    *(u32x4*)(O + off + bj * HALF) = w; } }
    }
};
struct EpiMix {
    static constexpr bool PERM = false, AFTER_DRAIN = false;
    const float* X; float* Y;
    __device__ __forceinline__ void operator()(const f32x4 (&acc)[2][2][4][2], const Unit& u, int wr, int wc, int fr, int fq) const {
        const int row0 = u.pm * BM + wr * 64 + fr, col0 = u.pn * BM + wc * 32 + 4 * fq;
#pragma unroll
        for (int ai = 0; ai < 2; ++ai)
#pragma unroll
            for (int m = 0; m < 4; ++m) { const size_t off = (size_t)(row0 + ai * HALF + m * 16) * 1024 + col0;
#pragma unroll
                for (int bj = 0; bj < 2; ++bj)
#pragma unroll
                    for (int n = 0; n < 2; ++n) { const f32x4 xv = *(const f32x4*)(X + off + bj * HALF + n * 16); *(f32x4*)(Y + off + bj * HALF + n * 16) = xv * ALPHA + acc[ai][bj][m][n]; } }
    }
};
}

struct Frame {
    LAS unsigned char* lds;
    volatile LAS unsigned* MISC;
    gu32* ctl;
    int tid, lane, wave, vcu, G;
};

__device__ __forceinline__ void transpose_item(const float* W, int ldw, int src_col0, bf16* WT, int K, int dst_row0, LAS float* scr, int k0, int lane) {
#pragma unroll 8
    for (int i = 0; i < 32; ++i) { const int kk = 2 * i + (lane >> 5); scr[kk * 33 + (lane & 31)] = W[(size_t)(k0 + kk) * ldw + src_col0 + (lane & 31)]; }
    LDS_WAIT(); asm volatile("" ::: "memory");
    const int c = lane & 7;
#pragma unroll
    for (int j = 0; j < 4; ++j) { const int n = (lane >> 3) + 8 * j; const LAS float* s = scr + (8 * c) * 33 + n;
        v4u o; o.x = pk2(s[0 * 33], s[1 * 33]); o.y = pk2(s[2 * 33], s[3 * 33]); o.z = pk2(s[4 * 33], s[5 * 33]); o.w = pk2(s[6 * 33], s[7 * 33]);
        *(GAS v4u*)(WT + (size_t)(dst_row0 + n) * K + k0 + 8 * c) = o; }
    LDS_WAIT(); asm volatile("" ::: "memory");
}
__device__ __forceinline__ void convert_flat(Frame& F, const float* src, bf16* dst, size_t n8) {
    const size_t gt = (size_t)F.vcu * 512 + F.tid, NT_ = (size_t)F.G * 512;
    for (size_t i = gt; i < n8; i += NT_) { const f32x4 a = *(const GAS f32x4*)(src + i * 8), b = *(const GAS f32x4*)(src + i * 8 + 4);
        v4u o; o.x = pk2(a.x, a.y); o.y = pk2(a.z, a.w); o.z = pk2(b.x, b.y); o.w = pk2(b.z, b.w); *(GAS v4u*)(dst + i * 8) = o; }
}

struct In {
    const float *x, *w_in, *fox_f_bias, *gla_gate_up, *gla_gate_bias, *gla_norm_gain, *w_out_fox, *w_out_gla, *w_out, *ln1_gain, *ln1_bias,
                *peer_w_query, *peer_sub_keys, *peer_expert_u, *peer_expert_v, *ln2_gain, *ln2_bias;
};

__device__ __forceinline__ void p0_prologue(Frame& F, const In& I, unsigned char* ws) {
    const int gw = F.vcu * NWAVES + F.wave, NGW = F.G * NWAVES;
    {
        LAS float* scr = (LAS float*)(F.lds + F.wave * 16384);
        constexpr int I_IN = 16 * 208, I_OF = 8 * 32, I_OG = 16 * 32, I_O = 16 * 32, I_Q = 16 * 64;
        constexpr int NITEMS = I_IN + I_OF + I_OG + I_O + I_Q;
        for (int it = gw; it < NITEMS; it += NGW) {
            int r = it;
            if (r < I_IN) { const int kb = r / 208, nb = r % 208; const int sc = 32 * nb + (nb >= 48 ? 8 : 0) + (nb >= 144 ? 16 : 0);
                transpose_item(I.w_in, 6680, sc, (bf16*)(ws + WS_WIN), 1024, 32 * nb, scr, 64 * kb, F.lane); continue; } r -= I_IN;
            if (r < I_OF) { const int kb = r / 32, nb = r % 32; transpose_item(I.w_out_fox, 1024, 32 * nb, (bf16*)(ws + WS_WOF), 512, 32 * nb, scr, 64 * kb, F.lane); continue; } r -= I_OF;
            if (r < I_OG) { const int kb = r / 32, nb = r % 32; transpose_item(I.w_out_gla, 1024, 32 * nb, (bf16*)(ws + WS_WOG), 1024, 32 * nb, scr, 64 * kb, F.lane); continue; } r -= I_OG;
            if (r < I_O)  { const int kb = r / 32, nb = r % 32; transpose_item(I.w_out, 1024, 32 * nb, (bf16*)(ws + WS_WO), 1024, 32 * nb, scr, 64 * kb, F.lane); continue; } r -= I_O;
            { const int kb = r / 64, nb = r % 64; transpose_item(I.peer_w_query, 2048, 32 * nb, (bf16*)(ws + WS_WQ), 1024, 32 * nb, scr, 64 * kb, F.lane); }
        }
    }
    convert_flat(F, I.peer_sub_keys, (bf16*)(ws + WS_SK), (size_t)8 * 2 * 128 * 128 / 8);
    convert_flat(F, I.peer_expert_u, (bf16*)(ws + WS_EU), (size_t)16384 * 1024 / 8);
    convert_flat(F, I.peer_expert_v, (bf16*)(ws + WS_EV), (size_t)16384 * 1024 / 8);
    __syncthreads();
    {
        LAS float* WSl = (LAS float*)F.lds;
        for (int idx = F.tid; idx < 24 * 1024; idx += 512) { const int k = idx / 24, j = idx % 24; const int col = j < 8 ? 1536 + j : 4616 + (j - 8);
            WSl[j * 1028 + k] = I.w_in[(size_t)k * 6680 + col]; }
        __syncthreads();
        float* FFo = (float*)(ws + WS_FF); float* GLRo = (float*)(ws + WS_GLR); bf16* XB = (bf16*)(ws + WS_XB);
        for (int m = gw; m < T; m += NGW) {
            const GAS f32x4* xr = (const GAS f32x4*)(I.x + (size_t)m * Dm) + F.lane;
            f32x4 v[4];
#pragma unroll
            for (int j = 0; j < 4; ++j) v[j] = xr[64 * j];
            GAS u64* o8 = (GAS u64*)(XB + (size_t)m * Dm) + F.lane;
#pragma unroll
            for (int j = 0; j < 4; ++j) o8[64 * j] = (u64)pk2(v[j].x, v[j].y) | ((u64)pk2(v[j].z, v[j].w) << 32);
            float mine = 0.f;
#pragma unroll 1
            for (int jo = 0; jo < 24; ++jo) { float s = 0.f;
#pragma unroll
                for (int j = 0; j < 4; ++j) { const f32x4 w = *(const LAS f32x4*)(WSl + jo * 1028 + 4 * F.lane + 256 * j); s += (v[j].x * w.x + v[j].y * w.y) + (v[j].z * w.z + v[j].w * w.w); }
                s = wave_sum(s); if (F.lane == jo) mine = s; }
            if (F.lane < 8) FFo[(size_t)m * 8 + F.lane] = mine; else if (F.lane < 24) GLRo[(size_t)m * 16 + (F.lane - 8)] = mine;
        }
    }
}

__device__ __forceinline__ void p1_forget_cumsum(Frame& F, const In& I, unsigned char* ws) {
    if (F.vcu >= 128) return;
    const int b = F.vcu >> 3, h = F.vcu & 7; const float fb = I.fox_f_bias[h];
    const float* FFi = (const float*)(ws + WS_FF); float* CB = (float*)(ws + WS_CB) + (size_t)F.vcu * Sn;
    LAS float* wt = (LAS float*)F.lds;
    float ls[4]; float run = 0.f;
#pragma unroll
    for (int j = 0; j < 4; ++j) { const float f = FFi[((size_t)b * Sn + 4 * F.tid + j) * 8 + h] + fb; const float l = fminf(f, 0.f) - __logf(1.0f + __expf(-fabsf(f))); run += l; ls[j] = run; }
    float inc = run;
#pragma unroll
    for (int o = 1; o < 64; o <<= 1) { const float t = __shfl_up(inc, o); if (F.lane >= o) inc += t; }
    if (F.lane == 63) wt[F.wave] = inc;
    __syncthreads();
    float woff = 0.f;
#pragma unroll
    for (int w = 0; w < 8; ++w) if (w < F.wave) woff += wt[w];
    const float off = woff + inc - run;
    f32x4 o; o.x = -8.f * (off + ls[0]); o.y = -8.f * (off + ls[1]); o.z = -8.f * (off + ls[2]); o.w = -8.f * (off + ls[3]);
    *(GAS f32x4*)(CB + 4 * F.tid) = o;
    __syncthreads();
}

namespace gla {
typedef __attribute__((address_space(3))) unsigned char* lptr;
typedef __attribute__((address_space(3))) const unsigned char* lcptr;
typedef short v4i16_t __attribute__((ext_vector_type(4)));
constexpr int KD_STRIDE = 320, V_STRIDE = 576, Q_STRIDE = 264, G_STRIDE = 520;
constexpr int L_KD = 0, L_V = 20480, L_Q = 57344, L_G = 74240, L_GLR = 107520, L_CT = 111616, L_DT = 113664, L_RS = 114176, GLA_LDS = 116224;
__device__ __forceinline__ s16x4v tr4(lcptr p) { return __builtin_bit_cast(s16x4v, __builtin_amdgcn_ds_read_tr16_b64_v4i16((__attribute__((address_space(3))) v4i16_t*)p)); }
__device__ __forceinline__ int crow(int r, int hi) { return (r & 3) + 8 * (r >> 2) + 4 * hi; }
typedef float f32x2_t __attribute__((ext_vector_type(2)));
__device__ __forceinline__ unsigned cvtpk(float lo, float hi) { const f32x2_t v = {lo, hi}; const bf16x2_t bb = __builtin_convertvector(v, bf16x2_t); return __builtin_bit_cast(unsigned, bb); }

struct Pre { v4u k[2], q[2], v[4], g[4], glr; };

__device__ __forceinline__ void load_chunk(Pre& P, int tid, size_t row0, int h, const bf16* GQ, const bf16* GK, const bf16* GV, const bf16* GG, const float* GLRi) {
#pragma unroll
    for (int j = 0; j < 2; ++j) { const int p = tid + 512 * j, row = p >> 4, c = p & 15;
        P.k[j] = *(const GAS v4u*)(GK + (row0 + row) * 512 + h * 128 + c * 8); P.q[j] = *(const GAS v4u*)(GQ + (row0 + row) * 512 + h * 128 + c * 8); }
#pragma unroll
    for (int j = 0; j < 4; ++j) { const int p = tid + 512 * j, row = p >> 5, c = p & 31;
        P.v[j] = *(const GAS v4u*)(GV + (row0 + row) * 1024 + h * 256 + c * 8); P.g[j] = *(const GAS v4u*)(GG + (row0 + row) * 1024 + h * 256 + c * 8); }
    if (tid < 256) P.glr = *(const GAS v4u*)(GLRi + row0 * 16 + tid * 4);
}
__device__ __forceinline__ void store_chunk(const Pre& P, int tid, lptr lds) {
#pragma unroll
    for (int j = 0; j < 2; ++j) { const int p = tid + 512 * j, row = p >> 4, c = p & 15;
        *(__attribute__((address_space(3))) v4u*)(lds + L_KD + row * KD_STRIDE + c * 16) = P.k[j];
        __attribute__((address_space(3))) v2u* qd = (__attribute__((address_space(3))) v2u*)(lds + L_Q + row * Q_STRIDE + c * 16);
        qd[0] = (v2u){P.q[j].x, P.q[j].y}; qd[1] = (v2u){P.q[j].z, P.q[j].w}; }
#pragma unroll
    for (int j = 0; j < 4; ++j) { const int p = tid + 512 * j, row = p >> 5, c = p & 31;
        *(__attribute__((address_space(3))) v4u*)(lds + L_V + row * V_STRIDE + c * 16) = P.v[j];
        __attribute__((address_space(3))) v2u* gd = (__attribute__((address_space(3))) v2u*)(lds + L_G + row * G_STRIDE + c * 16);
        gd[0] = (v2u){P.g[j].x, P.g[j].y}; gd[1] = (v2u){P.g[j].z, P.g[j].w}; }
    if (tid < 256) *(__attribute__((address_space(3))) v4u*)(lds + L_GLR + tid * 16) = P.glr;
}

__device__ __forceinline__ void gla_unit(int b, int h, const bf16* GQ, const bf16* GK, const bf16* GV, const bf16* GG, const float* GLRi,
                                         const float* up, const float* gbias, const float* gain, bf16* OG, lptr lds) {
    const int tid = threadIdx.x, lane = tid & 63, r32 = lane & 31, hi = lane >> 5; const int wid = __builtin_amdgcn_readfirstlane(tid >> 6);
    const int d = tid & 127, qt = tid >> 7;
    float upr[16];
#pragma unroll
    for (int r = 0; r < 16; ++r) upr[r] = up[r * 512 + h * 128 + d];
    const float bz = gbias[h * 128 + d];
    f32x16 S[4];
#pragma unroll
    for (int rb = 0; rb < 4; ++rb) S[rb] = f32x16{};
    const size_t rowb = (size_t)b * Sn;
    Pre P;
    load_chunk(P, tid, rowb, h, GQ, GK, GV, GG, GLRi);
    store_chunk(P, tid, lds);
    __syncthreads();
    const int G4 = lane >> 4, q4 = (lane & 15) >> 2, p4 = lane & 3, cb16 = G4 & 1;
    const lcptr a_base = (lcptr)lds + L_KD + (8 * hi + q4) * KD_STRIDE + (16 * cb16 + 4 * p4) * 2;
    const lcptr b_base = (lcptr)lds + L_V + (8 * hi + q4) * V_STRIDE + (32 * wid + 16 * cb16 + 4 * p4) * 2;
    for (int c = 0; c < 32; ++c) {
        if (c + 1 < 32) load_chunk(P, tid, rowb + (size_t)(c + 1) * 64, h, GQ, GK, GV, GG, GLRi);
        {
            float cumv[16]; float run = 0.f;
#pragma unroll
            for (int ii = 0; ii < 16; ++ii) { const __attribute__((address_space(3))) f32x4* gp = (const __attribute__((address_space(3))) f32x4*)(lds + L_GLR + (16 * qt + ii) * 64);
                const f32x4 g0 = gp[0], g1 = gp[1], g2 = gp[2], g3 = gp[3];
                float z = bz;
                z += g0.x * upr[0] + g0.y * upr[1] + g0.z * upr[2] + g0.w * upr[3];
                z += g1.x * upr[4] + g1.y * upr[5] + g1.z * upr[6] + g1.w * upr[7];
                z += g2.x * upr[8] + g2.y * upr[9] + g2.z * upr[10] + g2.w * upr[11];
                z += g3.x * upr[12] + g3.y * upr[13] + g3.z * upr[14] + g3.w * upr[15];
                const float la = (fminf(z, 0.f) - __logf(1.0f + __expf(-fabsf(z)))) * (1.0f / 16.0f);
                run += la; cumv[ii] = run; }
            __attribute__((address_space(3))) float* CT = (__attribute__((address_space(3))) float*)(lds + L_CT);
            CT[qt * 128 + d] = run;
            __syncthreads();
            const float t0 = CT[d], t1 = CT[128 + d], t2 = CT[256 + d], t3 = CT[384 + d];
            const float total = (t0 + t1) + (t2 + t3);
            const float off = (qt > 0 ? t0 : 0.f) + (qt > 1 ? t1 : 0.f) + (qt > 2 ? t2 : 0.f);
#pragma unroll
            for (int ii = 0; ii < 16; ++ii) { __attribute__((address_space(3))) unsigned short* kp = (__attribute__((address_space(3))) unsigned short*)(lds + L_KD + (16 * qt + ii) * KD_STRIDE + d * 2);
                const float kf = __builtin_bit_cast(float, (unsigned)(*kp) << 16) * __expf(total - (off + cumv[ii]));
                *kp = (unsigned short)f2bf(kf); }
            if (qt == 0) ((__attribute__((address_space(3))) float*)(lds + L_DT))[d] = __expf(total);
            __syncthreads();
        }
        {
#pragma unroll
            for (int rb = 0; rb < 4; ++rb)
#pragma unroll
                for (int g = 0; g < 4; ++g) { const f32x4 dt = *(const __attribute__((address_space(3))) f32x4*)(lds + L_DT + (32 * rb + 8 * g + 4 * hi) * 4);
                    S[rb][4 * g] *= dt.x; S[rb][4 * g + 1] *= dt.y; S[rb][4 * g + 2] *= dt.z; S[rb][4 * g + 3] *= dt.w; }
#pragma unroll
            for (int s = 0; s < 4; ++s) {
                const s16x4v b0 = tr4(b_base + s * 16 * V_STRIDE), b1 = tr4(b_base + s * 16 * V_STRIDE + 4 * V_STRIDE);
                const bf16x8 bf = (bf16x8){b0[0], b0[1], b0[2], b0[3], b1[0], b1[1], b1[2], b1[3]};
#pragma unroll
                for (int rb = 0; rb < 4; ++rb) {
                    const s16x4v a0 = tr4(a_base + s * 16 * KD_STRIDE + rb * 64), a1 = tr4(a_base + s * 16 * KD_STRIDE + 4 * KD_STRIDE + rb * 64);
                    const bf16x8 af = (bf16x8){a0[0], a0[1], a0[2], a0[3], a1[0], a1[1], a1[2], a1[3]};
                    S[rb] = __builtin_amdgcn_mfma_f32_32x32x16_bf16(af, bf, S[rb], 0, 0, 0);
                }
            }
        }
        f32x16 ob[2]; ob[0] = f32x16{}; ob[1] = f32x16{};
        {
#pragma unroll
            for (int rb = 0; rb < 4; ++rb)
#pragma unroll
                for (int s2 = 0; s2 < 2; ++s2) {
                    v4u sp; sp.x = cvtpk(S[rb][8 * s2 + 0], S[rb][8 * s2 + 1]); sp.y = cvtpk(S[rb][8 * s2 + 2], S[rb][8 * s2 + 3]);
                    sp.z = cvtpk(S[rb][8 * s2 + 4], S[rb][8 * s2 + 5]); sp.w = cvtpk(S[rb][8 * s2 + 6], S[rb][8 * s2 + 7]);
                    const bf16x8 sf = __builtin_bit_cast(bf16x8, sp);
#pragma unroll
                    for (int ib = 0; ib < 2; ++ib) {
                        const lcptr qrow = (lcptr)lds + L_Q + (32 * ib + r32) * Q_STRIDE + (32 * rb + 16 * s2 + 4 * hi) * 2;
                        const v2u lo = *(const __attribute__((address_space(3))) v2u*)(qrow), hi2 = *(const __attribute__((address_space(3))) v2u*)(qrow + 16);
                        const bf16x8 qf = __builtin_bit_cast(bf16x8, (v4u){lo.x, lo.y, hi2.x, hi2.y});
                        ob[ib] = __builtin_amdgcn_mfma_f32_32x32x16_bf16(sf, qf, ob[ib], 0, 0, 0);
                    }
                }
        }
        {
            __attribute__((address_space(3))) float* RS = (__attribute__((address_space(3))) float*)(lds + L_RS);
#pragma unroll
            for (int ib = 0; ib < 2; ++ib) { float ss = 0.f;
#pragma unroll
                for (int r = 0; r < 16; ++r) ss += ob[ib][r] * ob[ib][r];
                auto rr = __builtin_amdgcn_permlane32_swap(__float_as_uint(ss), __float_as_uint(ss), false, false); ss = __uint_as_float(rr[0]) + __uint_as_float(rr[1]);
                if (hi == 0) RS[wid * 64 + 32 * ib + r32] = ss; }
            __syncthreads();
#pragma unroll
            for (int ib = 0; ib < 2; ++ib) { const int i = 32 * ib + r32; float tot = 0.f;
#pragma unroll
                for (int w = 0; w < 8; ++w) tot += RS[w * 64 + i];
                const float rstd = __builtin_amdgcn_rsqf(tot * (1.0f / 256.0f) + GLA_EPS2);
#pragma unroll
                for (int g = 0; g < 4; ++g) { __attribute__((address_space(3))) v2u* gp = (__attribute__((address_space(3))) v2u*)(lds + L_G + i * G_STRIDE + (32 * wid + 8 * g + 4 * hi) * 2);
                    const v2u gg = *gp; const f32x4 gn = *(const GAS f32x4*)(gain + h * 256 + 32 * wid + 8 * g + 4 * hi);
                    const float x0 = bf_lo(gg.x), x1 = bf_hi(gg.x), x2 = bf_lo(gg.y), x3 = bf_hi(gg.y);
                    const float o0 = ob[ib][4 * g] * rstd * gn.x * (x0 * sigmoidf_(x0)), o1 = ob[ib][4 * g + 1] * rstd * gn.y * (x1 * sigmoidf_(x1));
                    const float o2 = ob[ib][4 * g + 2] * rstd * gn.z * (x2 * sigmoidf_(x2)), o3 = ob[ib][4 * g + 3] * rstd * gn.w * (x3 * sigmoidf_(x3));
                    *gp = (v2u){cvtpk(o0, o1), cvtpk(o2, o3)}; } }
            __syncthreads();
        }
        {
#pragma unroll
            for (int j = 0; j < 4; ++j) { const int p = tid + 512 * j, row = p >> 5, cc = p & 31;
                const __attribute__((address_space(3))) v2u* gs = (const __attribute__((address_space(3))) v2u*)(lds + L_G + row * G_STRIDE + cc * 16);
                const v2u a = gs[0], bb = gs[1];
                *(GAS v4u*)(OG + (rowb + (size_t)c * 64 + row) * 1024 + h * 256 + cc * 8) = (v4u){a.x, a.y, bb.x, bb.y}; }
            __syncthreads();
        }
        if (c + 1 < 32) { store_chunk(P, tid, lds); }
        __syncthreads();
    }
}
}

__device__ __forceinline__ void p7_ln1(Frame& F, const In& I, unsigned char* ws) {
    const int gw = F.vcu * NWAVES + F.wave, NGW = F.G * NWAVES;
    const float* Y = (const float*)(ws + WS_Y); bf16* X1 = (bf16*)(ws + WS_XB);
    f32x4 gv[4], bv[4];
#pragma unroll
    for (int j = 0; j < 4; ++j) { gv[j] = *((const GAS f32x4*)I.ln1_gain + F.lane + 64 * j); bv[j] = *((const GAS f32x4*)I.ln1_bias + F.lane + 64 * j); }
    for (int m = gw; m < T; m += NGW) {
        const GAS f32x4* yr = (const GAS f32x4*)(Y + (size_t)m * Dm) + F.lane;
        f32x4 v[4]; float s = 0.f;
#pragma unroll
        for (int j = 0; j < 4; ++j) { v[j] = yr[64 * j]; s += (v[j].x + v[j].y) + (v[j].z + v[j].w); }
        const float mean = wave_sum(s) * (1.f / Dm); float s2 = 0.f;
#pragma unroll
        for (int j = 0; j < 4; ++j) { v[j] = v[j] - mean; s2 += (v[j].x * v[j].x + v[j].y * v[j].y) + (v[j].z * v[j].z + v[j].w * v[j].w); }
        const float rstd = 1.f / sqrtf(wave_sum(s2) * (1.f / Dm) + LN_EPS);
        GAS u64* o8 = (GAS u64*)(X1 + (size_t)m * Dm) + F.lane;
#pragma unroll
        for (int j = 0; j < 4; ++j) { const f32x4 o = v[j] * rstd * gv[j] + bv[j]; o8[64 * j] = (u64)pk2(o.x, o.y) | ((u64)pk2(o.z, o.w) << 32); }
    }
}

namespace topk {
template <int LO, int CNT, bool DESC> __device__ __forceinline__ void bmerge(unsigned* k) {
    if constexpr (CNT > 1) { constexpr int H = CNT / 2;
#pragma unroll
        for (int i = 0; i < H; ++i) { const unsigned a = k[LO + i], b = k[LO + i + H]; const unsigned mx = a > b ? a : b, mn = a > b ? b : a; k[LO + i] = DESC ? mx : mn; k[LO + i + H] = DESC ? mn : mx; }
        bmerge<LO, H, DESC>(k); bmerge<LO + H, H, DESC>(k); }
}
template <int LO, int CNT, bool DESC> __device__ __forceinline__ void bsort(unsigned* k) {
    if constexpr (CNT > 1) { bsort<LO, CNT / 2, true>(k); bsort<LO + CNT / 2, CNT / 2, false>(k); bmerge<LO, CNT, DESC>(k); }
}
__device__ __forceinline__ void top16_of_64(unsigned* k) {
    bsort<0, 16, true>(k); bsort<16, 16, false>(k);
#pragma unroll
    for (int i = 0; i < 16; ++i) k[i] = k[i] > k[16 + i] ? k[i] : k[16 + i];
    bmerge<0, 16, true>(k);
    bsort<32, 16, true>(k); bsort<48, 16, false>(k);
#pragma unroll
    for (int i = 0; i < 16; ++i) k[32 + i] = k[32 + i] > k[48 + i] ? k[32 + i] : k[48 + i];
    bmerge<32, 16, false>(k);
#pragma unroll
    for (int i = 0; i < 16; ++i) k[i] = k[i] > k[32 + i] ? k[i] : k[32 + i];
    bmerge<0, 16, true>(k);
}
__device__ __forceinline__ void merge_halves(unsigned* k, int hi) {
    unsigned p[16];
#pragma unroll
    for (int i = 0; i < 16; ++i) { auto rr = __builtin_amdgcn_permlane32_swap(k[i], k[i], false, false); p[i] = hi ? rr[0] : rr[1]; }
#pragma unroll
    for (int i = 0; i < 16; ++i) k[i] = k[i] > p[15 - i] ? k[i] : p[15 - i];
    bmerge<0, 16, true>(k);
}
__device__ __forceinline__ unsigned fmap(float f) { const unsigned u = __float_as_uint(f); const unsigned m = (unsigned)((int)u >> 31); return u ^ (m | 0x80000000u); }
__device__ __forceinline__ float funmap(unsigned k) { const unsigned m = (unsigned)((int)k >> 31); return __uint_as_float(k ^ (~m | 0x80000000u)); }
struct CandTab { unsigned char i[50], j[50]; };
__host__ __device__ constexpr CandTab make_cands() { CandTab t{}; int n = 0; for (int i = 0; i < 16; ++i) for (int j = 0; j < 16; ++j) if ((i + 1) * (j + 1) <= 16) { t.i[n] = (unsigned char)i; t.j[n] = (unsigned char)j; ++n; } return t; }
constexpr CandTab CT_ = make_cands();
constexpr int SK_LDS = 65536, NL_OFF = 65536;

__device__ __forceinline__ void task(int t0, int h, const bf16* QP, unsigned short* IDX, float* GATE, __attribute__((address_space(3))) const unsigned char* SKl,
                                     __attribute__((address_space(3))) unsigned char* NL, int lane) {
    const int r32 = lane & 31, hi = lane >> 5;
    unsigned K0[16], K1[16];
#pragma unroll
    for (int p = 0; p < 2; ++p) {
        bf16x8 qf[8];
#pragma unroll
        for (int ks = 0; ks < 8; ++ks) qf[ks] = *(const GAS bf16x8*)(QP + (size_t)(t0 + r32) * 2048 + h * 256 + p * 128 + 16 * ks + 8 * hi);
        f32x16 acc[4];
#pragma unroll
        for (int nb = 0; nb < 4; ++nb) { acc[nb] = f32x16{};
#pragma unroll
            for (int ks = 0; ks < 8; ++ks) { const int n = 32 * nb + r32;
                const bf16x8 af = *(const __attribute__((address_space(3))) bf16x8*)(SKl + p * 32768 + n * 256 + (((2 * ks + hi) ^ (n & 15)) << 4));
                acc[nb] = __builtin_amdgcn_mfma_f32_32x32x16_bf16(af, qf[ks], acc[nb], 0, 0, 0); } }
        unsigned k[64];
#pragma unroll
        for (int nb = 0; nb < 4; ++nb)
#pragma unroll
            for (int r = 0; r < 16; ++r) k[16 * nb + r] = (fmap(acc[nb][r]) & ~127u) | (unsigned)(32 * nb + (r & 3) + 8 * (r >> 2)) | (unsigned)(4 * hi);
        top16_of_64(k);
        merge_halves(k, hi);
#pragma unroll
        for (int i = 0; i < 16; ++i) { if (p == 0) K0[i] = k[i]; else K1[i] = k[i]; }
    }
    { unsigned w0 = 0, w1 = 0, w2 = 0, w3 = 0;
#pragma unroll
      for (int i = 0; i < 4; ++i) { const unsigned a = hi ? K1[i] : K0[i], b = hi ? K1[4 + i] : K0[4 + i], c = hi ? K1[8 + i] : K0[8 + i], d = hi ? K1[12 + i] : K0[12 + i];
          w0 |= (a & 127u) << (8 * i); w1 |= (b & 127u) << (8 * i); w2 |= (c & 127u) << (8 * i); w3 |= (d & 127u) << (8 * i); }
      *(__attribute__((address_space(3))) v4u*)(NL + r32 * 32 + hi * 16) = (v4u){w0, w1, w2, w3}; }
    float v0[16], v1[16];
#pragma unroll
    for (int i = 0; i < 16; ++i) { v0[i] = funmap(K0[i] & ~127u); v1[i] = funmap(K1[i] & ~127u); }
    unsigned k[64];
#pragma unroll
    for (int c = 0; c < 64; ++c) { if (c < 50) { const float s = v0[CT_.i[c]] + v1[CT_.j[c]]; k[c] = (fmap(s) & ~255u) | (unsigned)(CT_.i[c] * 16 + CT_.j[c]); } else k[c] = 0u; }
    top16_of_64(k);
    float best[16]; float sum = 0.f; const float mx = funmap(k[0] & ~255u);
#pragma unroll
    for (int r = 0; r < 16; ++r) { best[r] = __expf(funmap(k[r] & ~255u) - mx); sum += best[r]; }
    const float rs = 1.0f / sum;
    asm volatile("s_waitcnt lgkmcnt(0)" ::: "memory");
    unsigned short idx[8]; float gt[8];
#pragma unroll
    for (int r = 0; r < 8; ++r) { const unsigned kk = hi ? k[8 + r] : k[r]; const float g = (hi ? best[8 + r] : best[r]) * rs;
        const unsigned n0 = NL[r32 * 32 + ((kk >> 4) & 15u)], n1 = NL[r32 * 32 + 16 + (kk & 15u)];
        idx[r] = (unsigned short)(n0 * 128u + n1); gt[r] = g; }
    v4u iw; iw.x = idx[0] | ((unsigned)idx[1] << 16); iw.y = idx[2] | ((unsigned)idx[3] << 16); iw.z = idx[4] | ((unsigned)idx[5] << 16); iw.w = idx[6] | ((unsigned)idx[7] << 16);
    const size_t t = (size_t)(t0 + r32);
    *(GAS v4u*)(IDX + t * 128 + h * 16 + 8 * hi) = iw;
    *(GAS f32x4*)(GATE + t * 128 + h * 16 + 8 * hi) = (f32x4){gt[0], gt[1], gt[2], gt[3]};
    *(GAS f32x4*)(GATE + t * 128 + h * 16 + 8 * hi + 4) = (f32x4){gt[4], gt[5], gt[6], gt[7]};
    asm volatile("s_waitcnt lgkmcnt(0)" ::: "memory");
}
}

__device__ __forceinline__ void p9_topk(Frame& F, unsigned char* ws) {
    const int h = F.vcu & 7, cg = F.vcu >> 3;
    const bf16* SK = (const bf16*)(ws + WS_SK) + (size_t)h * 32768;
    for (int g = F.tid; g < 4096; g += 512) { const int p = g >> 11, n = (g >> 4) & 127, ch = g & 15;
        *(LAS v4u*)(F.lds + p * 32768 + n * 256 + ((ch ^ (n & 15)) << 4)) = *(const GAS v4u*)(SK + (size_t)g * 8); }
    __syncthreads();
    for (int j = 0; j < 4; ++j) { const int tg = cg * 32 + F.wave * 4 + j;
        topk::task(tg * 32, h, (const bf16*)(ws + WS_QP), (unsigned short*)(ws + WS_IDX), (float*)(ws + WS_GATE), F.lds, F.lds + topk::NL_OFF + F.wave * 1024, F.lane); }
    __syncthreads();
}

__device__ __forceinline__ void p10_experts(Frame& F, const In& I, unsigned char* ws, float* out) {
    const int gw = F.vcu * NWAVES + F.wave, NGW = F.G * NWAVES; const int lane = F.lane;
    const bf16* X1 = (const bf16*)(ws + WS_XB); const bf16* EU = (const bf16*)(ws + WS_EU); const bf16* EV = (const bf16*)(ws + WS_EV);
    const unsigned short* IDX = (const unsigned short*)(ws + WS_IDX); const float* GATE = (const float*)(ws + WS_GATE);
    const int sel = ((lane >> 5) & 1) * 4 + ((lane >> 4) & 1) * 2 + ((lane >> 3) & 1);
    for (int t = gw; t < T; t += NGW) {
        const v4u h0 = *(const GAS v4u*)(X1 + (size_t)t * Dm + 8 * lane), h1 = *(const GAS v4u*)(X1 + (size_t)t * Dm + 512 + 8 * lane);
        const unsigned ia = IDX[(size_t)t * 128 + lane], ib = IDX[(size_t)t * 128 + 64 + lane];
        const float ga = GATE[(size_t)t * 128 + lane], gb = GATE[(size_t)t * 128 + 64 + lane];
        float acc[16];
#pragma unroll
        for (int i = 0; i < 16; ++i) acc[i] = 0.f;
#if defined(MK_X5)
        for (int kx = 0; kx < 128; ++kx) {
            const int e1 = __builtin_amdgcn_readlane(kx < 64 ? ia : ib, kx & 63);
            const float g1 = __builtin_bit_cast(float, __builtin_amdgcn_readlane(__builtin_bit_cast(int, kx < 64 ? ga : gb), kx & 63));
            const bf16* up = EU + (size_t)e1 * Dm; const v4u a0 = *(const GAS v4u*)(up + 8 * lane), a1 = *(const GAS v4u*)(up + 512 + 8 * lane);
            float s = bf_lo(a0.x) * bf_lo(h0.x) + bf_hi(a0.x) * bf_hi(h0.x) + bf_lo(a0.y) * bf_lo(h0.y) + bf_hi(a0.y) * bf_hi(h0.y) + bf_lo(a0.z) * bf_lo(h0.z) + bf_hi(a0.z) * bf_hi(h0.z) + bf_lo(a0.w) * bf_lo(h0.w) + bf_hi(a0.w) * bf_hi(h0.w)
                    + bf_lo(a1.x) * bf_lo(h1.x) + bf_hi(a1.x) * bf_hi(h1.x) + bf_lo(a1.y) * bf_lo(h1.y) + bf_hi(a1.y) * bf_hi(h1.y) + bf_lo(a1.z) * bf_lo(h1.z) + bf_hi(a1.z) * bf_hi(h1.z) + bf_lo(a1.w) * bf_lo(h1.w) + bf_hi(a1.w) * bf_hi(h1.w);
            s = wave_sum(s);
            const float w1 = gelu_erf(s) * g1;
            const bf16* vp = EV + (size_t)e1 * Dm; const v4u b0 = *(const GAS v4u*)(vp + 8 * lane), b1 = *(const GAS v4u*)(vp + 512 + 8 * lane);
            acc[0] += w1 * bf_lo(b0.x); acc[1] += w1 * bf_hi(b0.x); acc[2] += w1 * bf_lo(b0.y); acc[3] += w1 * bf_hi(b0.y); acc[4] += w1 * bf_lo(b0.z); acc[5] += w1 * bf_hi(b0.z); acc[6] += w1 * bf_lo(b0.w); acc[7] += w1 * bf_hi(b0.w);
            acc[8] += w1 * bf_lo(b1.x); acc[9] += w1 * bf_hi(b1.x); acc[10] += w1 * bf_lo(b1.y); acc[11] += w1 * bf_hi(b1.y); acc[12] += w1 * bf_lo(b1.z); acc[13] += w1 * bf_hi(b1.z); acc[14] += w1 * bf_lo(b1.w); acc[15] += w1 * bf_hi(b1.w);
        }
        for (int bt = 0; bt < 0; ++bt) {
#else
        for (int bt = 0; bt < 16; ++bt) {
#endif
            int e[8];
#pragma unroll
            for (int j = 0; j < 8; ++j) { const int kx = 8 * bt + j; e[j] = __builtin_amdgcn_readlane(kx < 64 ? ia : ib, kx & 63); }
            v4u u0[8], u1[8];
#pragma unroll
            for (int j = 0; j < 8; ++j) { const bf16* up = EU + (size_t)e[j] * Dm; u0[j] = *(const GAS v4u*)(up + 8 * lane); u1[j] = *(const GAS v4u*)(up + 512 + 8 * lane); }
            float p[8];
#pragma unroll
            for (int j = 0; j < 8; ++j) { float s = 0.f;
                s = __builtin_amdgcn_fdot2_f32_bf16(__builtin_bit_cast(bf16x2_t, u0[j].x), __builtin_bit_cast(bf16x2_t, h0.x), s, false);
                s = __builtin_amdgcn_fdot2_f32_bf16(__builtin_bit_cast(bf16x2_t, u0[j].y), __builtin_bit_cast(bf16x2_t, h0.y), s, false);
                s = __builtin_amdgcn_fdot2_f32_bf16(__builtin_bit_cast(bf16x2_t, u0[j].z), __builtin_bit_cast(bf16x2_t, h0.z), s, false);
                s = __builtin_amdgcn_fdot2_f32_bf16(__builtin_bit_cast(bf16x2_t, u0[j].w), __builtin_bit_cast(bf16x2_t, h0.w), s, false);
                s = __builtin_amdgcn_fdot2_f32_bf16(__builtin_bit_cast(bf16x2_t, u1[j].x), __builtin_bit_cast(bf16x2_t, h1.x), s, false);
                s = __builtin_amdgcn_fdot2_f32_bf16(__builtin_bit_cast(bf16x2_t, u1[j].y), __builtin_bit_cast(bf16x2_t, h1.y), s, false);
                s = __builtin_amdgcn_fdot2_f32_bf16(__builtin_bit_cast(bf16x2_t, u1[j].z), __builtin_bit_cast(bf16x2_t, h1.z), s, false);
                s = __builtin_amdgcn_fdot2_f32_bf16(__builtin_bit_cast(bf16x2_t, u1[j].w), __builtin_bit_cast(bf16x2_t, h1.w), s, false);
                p[j] = s; }
            float q4[4], q2[2], q1;
            { const bool up_ = (lane & 32) != 0;
#pragma unroll
              for (int j = 0; j < 4; ++j) { const float send = up_ ? p[j] : p[4 + j], keep = up_ ? p[4 + j] : p[j]; q4[j] = keep + __shfl_xor(send, 32); } }
            { const bool up_ = (lane & 16) != 0;
#pragma unroll
              for (int j = 0; j < 2; ++j) { const float send = up_ ? q4[j] : q4[2 + j], keep = up_ ? q4[2 + j] : q4[j]; q2[j] = keep + __shfl_xor(send, 16); } }
            { const bool up_ = (lane & 8) != 0; const float send = up_ ? q2[0] : q2[1], keep = up_ ? q2[1] : q2[0]; q1 = keep + __shfl_xor(send, 8); }
            q1 += __shfl_xor(q1, 4); q1 += __shfl_xor(q1, 2); q1 += __shfl_xor(q1, 1);
            const int kx = 8 * bt + sel;
            const float gsel = __shfl(kx < 64 ? ga : gb, kx & 63);
            const float wv = gelu_erf(q1) * gsel;
            float w[8];
#pragma unroll
            for (int j = 0; j < 8; ++j) w[j] = __builtin_amdgcn_readlane(wv, ((j >> 2) & 1) * 32 + ((j >> 1) & 1) * 16 + (j & 1) * 8);
            v4u x0[8], x1[8];
#pragma unroll
            for (int j = 0; j < 8; ++j) { const bf16* vp = EV + (size_t)e[j] * Dm; x0[j] = *(const GAS v4u*)(vp + 8 * lane); x1[j] = *(const GAS v4u*)(vp + 512 + 8 * lane); }
#pragma unroll
            for (int j = 0; j < 8; ++j) {
                acc[0] += w[j] * bf_lo(x0[j].x); acc[1] += w[j] * bf_hi(x0[j].x); acc[2] += w[j] * bf_lo(x0[j].y); acc[3] += w[j] * bf_hi(x0[j].y);
                acc[4] += w[j] * bf_lo(x0[j].z); acc[5] += w[j] * bf_hi(x0[j].z); acc[6] += w[j] * bf_lo(x0[j].w); acc[7] += w[j] * bf_hi(x0[j].w);
                acc[8] += w[j] * bf_lo(x1[j].x); acc[9] += w[j] * bf_hi(x1[j].x); acc[10] += w[j] * bf_lo(x1[j].y); acc[11] += w[j] * bf_hi(x1[j].y);
                acc[12] += w[j] * bf_lo(x1[j].z); acc[13] += w[j] * bf_hi(x1[j].z); acc[14] += w[j] * bf_lo(x1[j].w); acc[15] += w[j] * bf_hi(x1[j].w); }
        }
#if defined(MK_X3)
        _Pragma("unroll") for (int i = 0; i < 16; ++i) acc[i] = 0.f;
#endif
        float y[16];
        y[0] = ALPHA * bf_lo(h0.x) + acc[0]; y[1] = ALPHA * bf_hi(h0.x) + acc[1]; y[2] = ALPHA * bf_lo(h0.y) + acc[2]; y[3] = ALPHA * bf_hi(h0.y) + acc[3];
        y[4] = ALPHA * bf_lo(h0.z) + acc[4]; y[5] = ALPHA * bf_hi(h0.z) + acc[5]; y[6] = ALPHA * bf_lo(h0.w) + acc[6]; y[7] = ALPHA * bf_hi(h0.w) + acc[7];
        y[8] = ALPHA * bf_lo(h1.x) + acc[8]; y[9] = ALPHA * bf_hi(h1.x) + acc[9]; y[10] = ALPHA * bf_lo(h1.y) + acc[10]; y[11] = ALPHA * bf_hi(h1.y) + acc[11];
        y[12] = ALPHA * bf_lo(h1.z) + acc[12]; y[13] = ALPHA * bf_hi(h1.z) + acc[13]; y[14] = ALPHA * bf_lo(h1.w) + acc[14]; y[15] = ALPHA * bf_hi(h1.w) + acc[15];
        float s = 0.f;
#pragma unroll
        for (int i = 0; i < 16; ++i) s += y[i];
        const float mean = wave_sum(s) * (1.f / Dm); float s2 = 0.f;
#pragma unroll
        for (int i = 0; i < 16; ++i) { y[i] -= mean; s2 += y[i] * y[i]; }
        const float rstd = 1.f / sqrtf(wave_sum(s2) * (1.f / Dm) + LN_EPS);
#pragma unroll
        for (int c = 0; c < 2; ++c) { const int col = 512 * c + 8 * lane;
            const f32x4 g0 = *(const GAS f32x4*)(I.ln2_gain + col), g1 = *(const GAS f32x4*)(I.ln2_gain + col + 4), b0 = *(const GAS f32x4*)(I.ln2_bias + col), b1 = *(const GAS f32x4*)(I.ln2_bias + col + 4);
            f32x4 o0, o1;
            o0.x = y[8 * c + 0] * rstd * g0.x + b0.x; o0.y = y[8 * c + 1] * rstd * g0.y + b0.y; o0.z = y[8 * c + 2] * rstd * g0.z + b0.z; o0.w = y[8 * c + 3] * rstd * g0.w + b0.w;
            o1.x = y[8 * c + 4] * rstd * g1.x + b1.x; o1.y = y[8 * c + 5] * rstd * g1.y + b1.y; o1.z = y[8 * c + 6] * rstd * g1.z + b1.z; o1.w = y[8 * c + 7] * rstd * g1.w + b1.w;
            *(GAS f32x4*)(out + (size_t)t * Dm + col) = o0; *(GAS f32x4*)(out + (size_t)t * Dm + col + 4) = o1; }
    }
}

struct Args { const float* in[17]; float* out; unsigned char* ws; int ph_lo, ph_hi, li, pad; };
__global__ void __launch_bounds__(NWAVES * 64, 2) mk_fwd(Args args) {
    extern __shared__ __attribute__((aligned(16))) unsigned char lds[];
    Frame F;
    F.lds = (LAS unsigned char*)lds;
    F.MISC = (volatile LAS unsigned*)(F.lds + MISC_OFF);
    F.tid = threadIdx.x; F.lane = F.tid & 63; F.wave = __builtin_amdgcn_readfirstlane(F.tid >> 6);
    F.G = gridDim.x; { const int bx = blockIdx.x; F.vcu = (F.G % 8 == 0) ? (bx % 8) * (F.G / 8) + bx / 8 : bx; }
    unsigned char* ws = args.ws;
    F.ctl = (gu32*)(ws + WS_CTL);
    In I; I.x = args.in[0]; I.w_in = args.in[1]; I.fox_f_bias = args.in[2]; I.gla_gate_up = args.in[3]; I.gla_gate_bias = args.in[4]; I.gla_norm_gain = args.in[5];
    I.w_out_fox = args.in[6]; I.w_out_gla = args.in[7]; I.w_out = args.in[8]; I.ln1_gain = args.in[9]; I.ln1_bias = args.in[10]; I.peer_w_query = args.in[11];
    I.peer_sub_keys = args.in[12]; I.peer_expert_u = args.in[13]; I.peer_expert_v = args.in[14]; I.ln2_gain = args.in[15]; I.ln2_bias = args.in[16];
    for (int u = F.tid; u < (LDS_BYTES - LDSCTL_OFF) / 4; u += NWAVES * 64) ((LAS unsigned*)(F.lds + LDSCTL_OFF))[u] = 0u;
    __syncthreads();
    XcdBarrier bar = xcd_barrier_post((unsigned*)(F.ctl + CW_BAR) + args.li * XCD_BAR_WORDS, F.MISC + 8);
    const int lo = args.ph_lo, hi = args.ph_hi;
#ifndef MK_ONLY
#define MK_ONLY -1
#endif
#define IN(k) ((MK_ONLY < 0 || MK_ONLY == (k)) && lo <= (k) && (k) < hi)
#define SEAM(k) do { if (IN(k) && IN((k) + 1)) xcd_barrier(bar); } while (0)

    if (IN(0)) { p0_prologue(F, I, ws); } SEAM(0);

    if (IN(1)) {
        p1_forget_cumsum(F, I, ws);
        pg8::Gemm g{(const pg8::bf16_t*)(ws + WS_XB), (const pg8::bf16_t*)(ws + WS_WIN), T, NPROJ, Dm}; pg8::StaticOrder S; S.init(T, NPROJ, F.G, (int)blockIdx.x);
        pg8::EpiProj E{ws, (unsigned char*)args.out};
        pg8::gemm_phase<pg8::EpiProj, pg8::StaticOrder, true, true>(F.lds, g, S, E);
    } SEAM(1);

    if (IN(2)) {
        const int c = F.vcu, bh = c >> 1, odd = c & 1;
        for (int i = 0; i < 4; ++i) { const int qb = odd ? (i == 0 ? 6 : i == 1 ? 1 : i == 2 ? 4 : 3) : (i == 0 ? 7 : i == 1 ? 0 : i == 2 ? 5 : 2);
            fox::attn64_unit(bh >> 3, bh & 7, qb, (const fox::bf16*)(ws + WS_FQ), (const fox::bf16*)(ws + WS_FK), (const fox::bf16*)(ws + WS_FV), (fox::bf16*)(ws + WS_FQ),
                             (const float*)(ws + WS_CB), (char*)lds); }
    }
    if (IN(3)) {
#if defined(MK_X1)
        { v4u z4 = (v4u){0u,0u,0u,0u}; for (size_t i = (size_t)F.vcu * 512 + F.tid; i < (size_t)T * 1024 / 8; i += (size_t)F.G * 512) *(GAS v4u*)((bf16*)(ws + WS_GV) + i * 8) = z4; }
        if (false)
#else
        if (F.vcu < 64)
#endif
            gla::gla_unit(F.vcu >> 2, F.vcu & 3, (const bf16*)(ws + WS_GQ), (const bf16*)(ws + WS_GK), (const bf16*)(ws + WS_GV), (const bf16*)(ws + WS_GG), (const float*)(ws + WS_GLR),
                                      I.gla_gate_up, I.gla_gate_bias, I.gla_norm_gain, (bf16*)(ws + WS_GV), F.lds);
    } SEAM(3);

    if (IN(4)) {
        pg8::Gemm g{(const pg8::bf16_t*)(ws + WS_FQ), (const pg8::bf16_t*)(ws + WS_WOF), T, Dm, 512}; pg8::StaticOrder S; S.init(T, Dm, F.G, (int)blockIdx.x);
        pg8::EpiGate<0> E{(const pg8::bf16_t*)args.out, (pg8::bf16_t*)(ws + WS_XB)};
        pg8::gemm_phase<pg8::EpiGate<0>, pg8::StaticOrder, true, true>(F.lds, g, S, E);
    } SEAM(4);
    if (IN(5)) {
        pg8::Gemm g{(const pg8::bf16_t*)(ws + WS_GV), (const pg8::bf16_t*)(ws + WS_WOG), T, Dm, Dm}; pg8::StaticOrder S; S.init(T, Dm, F.G, (int)blockIdx.x);
        pg8::EpiGate<1> E{(const pg8::bf16_t*)((unsigned char*)args.out + 64 * MiB), (pg8::bf16_t*)(ws + WS_XB)};
        pg8::gemm_phase<pg8::EpiGate<1>, pg8::StaticOrder, true, true>(F.lds, g, S, E);
    } SEAM(5);
    if (IN(6)) {
        pg8::Gemm g{(const pg8::bf16_t*)(ws + WS_XB), (const pg8::bf16_t*)(ws + WS_WO), T, Dm, Dm}; pg8::StaticOrder S; S.init(T, Dm, F.G, (int)blockIdx.x);
        pg8::EpiMix E{I.x, (float*)(ws + WS_Y)};
        pg8::gemm_phase<pg8::EpiMix, pg8::StaticOrder, true, true>(F.lds, g, S, E);
    } SEAM(6);
    if (IN(7)) { p7_ln1(F, I, ws); } SEAM(7);
    if (IN(8)) {
        pg8::Gemm g{(const pg8::bf16_t*)(ws + WS_XB), (const pg8::bf16_t*)(ws + WS_WQ), T, 2048, Dm}; pg8::StaticOrder S; S.init(T, 2048, F.G, (int)blockIdx.x);
        pg8::EpiBf16<0> E{(pg8::bf16_t*)(ws + WS_QP), 2048, nullptr, 0, 0, 1.f};
        pg8::gemm_phase<pg8::EpiBf16<0>, pg8::StaticOrder, true, true>(F.lds, g, S, E);
    } SEAM(8);
    if (IN(9)) { p9_topk(F, ws); } SEAM(9);
    if (IN(10)) { p10_experts(F, I, ws, args.out); }
#undef IN
#undef SEAM
}

extern "C" void kernel_launch(void* const* d_in, const int* in_sizes, int n_in, void* d_out, int out_size, void* d_ws, size_t ws_size, hipStream_t stream) {
    static int grid = 0;
    if (grid == 0) {
        if (n_in != 17 || in_sizes[0] != T * Dm || out_size != T * Dm || ws_size < WS_END) { fprintf(stderr, "kernel_launch: unexpected shapes or workspace (n_in %d, in0 %d, out %d, ws %zu)\n", n_in, n_in > 0 ? in_sizes[0] : -1, out_size, ws_size); grid = -1; return; }
        int dev = 0, cus = 0, per_cu = 0;
        if (hipGetDevice(&dev) != hipSuccess || hipDeviceGetAttribute(&cus, hipDeviceAttributeMultiprocessorCount, dev) != hipSuccess) { grid = -1; return; }
        if (hipFuncSetAttribute((const void*)mk_fwd, hipFuncAttributeMaxDynamicSharedMemorySize, LDS_BYTES) != hipSuccess) { fprintf(stderr, "kernel_launch: hipFuncSetAttribute failed\n"); grid = -1; return; }
        if (hipOccupancyMaxActiveBlocksPerMultiprocessor(&per_cu, (const void*)mk_fwd, NWAVES * 64, LDS_BYTES) != hipSuccess || per_cu < 1) fprintf(stderr, "kernel_launch: occupancy query reports %d\n", per_cu);
        (void)hipGetLastError();
        grid = cus;
        if (grid != 256) { fprintf(stderr, "kernel_launch: built for 256 CUs, found %d\n", grid); grid = -1; return; }
    }
    if (grid < 0) return;
    if (hipMemsetAsync((char*)d_ws + WS_CTL, 0, CTL_ZERO_BYTES, stream) != hipSuccess) return;
    Args a{};
    for (int i = 0; i < 17; ++i) a.in[i] = (const float*)d_in[i];
    a.out = (float*)d_out; a.ws = (unsigned char*)d_ws;
#if MK_N_LAUNCHES == 1
    a.ph_lo = 0; a.ph_hi = N_PHASES; a.li = 0;
    hipLaunchKernelGGL(mk_fwd, dim3(grid), dim3(NWAVES * 64), LDS_BYTES, stream, a);
#else
    for (int li = 0; li < N_PHASES; ++li) { a.ph_lo = li; a.ph_hi = li + 1; a.li = li; if (li == 2) { a.ph_hi = 4; } if (li == 3) continue;
        hipLaunchKernelGGL(mk_fwd, dim3(grid), dim3(NWAVES * 64), LDS_BYTES, stream, a); }
#endif
}
```

```cpp
#include <hip/hip_runtime.h>
#include <hip/hip_bf16.h>
#include <cstdio>
#include <cstdint>
#include <cmath>
namespace pg8 {
#define PG8_LAS __attribute__((address_space(3)))
typedef unsigned short bf16_t;
typedef short bf16x8 __attribute__((ext_vector_type(8)));
typedef float f32x4 __attribute__((ext_vector_type(4)));
typedef unsigned u32x4 __attribute__((ext_vector_type(4)));
constexpr int BM = 256, BK = 64, HALF = 128, HTB = HALF * BK * 2  , STAGE_BYTES = 8 * HTB, NXCD = 8, WGM = 8;

__host__ __device__ __forceinline__ int lds_byte(int r, int c) { const int st = (r >> 4) * 2 + (c >> 5), rr = r & 15, cc = c & 31, ob = rr * 64 + cc * 2; return st * 1024 + (ob ^ (((ob >> 9) & 1) << 5)); }
__host__ __device__ __forceinline__ void stage_rc(int b, int& R, int& C) { const int st = b / 1024, sb = b % 1024, swz = sb ^ (((sb >> 9) & 1) << 5); R = (st >> 1) * 16 + swz / 64; C = (st & 1) * 32 + (swz % 64) / 2; }
__host__ __device__ __forceinline__ int perm32(int rho) { const int n = rho >> 4, i = rho & 15; return 8 * (i >> 2) + 4 * n + (i & 3); }

struct Unit { int pm, pn; };
struct Gemm { const bf16_t* A; const bf16_t* Bt; int M, N, K; };

struct StaticOrder {
    int nM, nN, nwg, G, c;
    __host__ __device__ void init(int M, int N, int G_, int c_) { nM = M / BM; nN = N / BM; nwg = nM * nN; G = G_; c = c_; }
    __host__ __device__ bool next(int i, Unit& u) const {
        const long L = (long)i * G + c; if (L >= nwg) return false;
        int wgid = (int)L; { const int q = nwg / NXCD, r = nwg % NXCD, xcd = wgid % NXCD, off = wgid / NXCD; wgid = (xcd < r ? xcd * (q + 1) : r * (q + 1) + (xcd - r) * q) + off; }
        const int nig = WGM * nN, gid = wgid / nig, fm = gid * WGM, gsz = (nM - fm) < WGM ? (nM - fm) : WGM;
        u.pm = fm + ((wgid % nig) % gsz); u.pn = (wgid % nig) / gsz; return true;
    }
    __device__ __forceinline__ void a_ready(const Unit&) const {}
    __device__ __forceinline__ void done(const Unit&) const {}
};

__device__ __forceinline__ unsigned cvt_pk_bf16(float lo, float hi) { unsigned r; asm volatile("v_cvt_pk_bf16_f32 %0, %1, %2" : "=v"(r) : "v"(lo), "v"(hi)); return r; }
typedef float f32x2 __attribute__((ext_vector_type(2)));
__device__ __forceinline__ f32x2 gelu_pk(f32x2 v) {
    const f32x2 av = __builtin_elementwise_abs(v), d = av * 0.2316418882f + 1.0f;
    f32x2 t; t.x = __builtin_amdgcn_rcpf(d.x); t.y = __builtin_amdgcn_rcpf(d.y);
    f32x2 q = t * 0.5307027145f + (-0.7265760135f); q = q * t + 0.7107068705f; q = q * t + (-0.142248368f); q = q * t + 0.127414796f; q = q * t;
    const f32x2 s = (v * v) * (-0.72134752044f);
    f32x2 e; e.x = __builtin_amdgcn_exp2f(s.x); e.y = __builtin_amdgcn_exp2f(s.y);
    const f32x2 m = v * (q * e), r = v - m;
    f32x2 o; o.x = v.x < 0.f ? m.x : r.x; o.y = v.y < 0.f ? m.y : r.y; return o;
}

template <int ACT  > struct EpiBf16 {
    static constexpr bool PERM = true, AFTER_DRAIN = false; static_assert(ACT == 0 || ACT == 1, "EpiBf16: ACT is 0 (none) or 1 (gelu_pk)");
    bf16_t* O; int ldc; const float* bias; int split_cols; size_t split_stride; float scale0;
    __device__ __forceinline__ void operator()(const f32x4 (&acc)[2][2][4][2], const Unit& u, int wr, int wc, int fr, int fq) const {
        const int row0 = u.pm * BM + wr * 64 + fr; int colt = u.pn * BM; bf16_t* base = O;
        float sc = 1.f; if (split_cols) { const int t = colt / split_cols; base += (size_t)t * split_stride; colt -= t * split_cols; if (t == 0) sc = scale0; }
        const int col0 = colt + wc * 32 + 8 * fq, bcol0 = u.pn * BM + wc * 32 + 8 * fq;
        f32x4 bv[2][2];
#pragma unroll
        for (int bj = 0; bj < 2; ++bj)
#pragma unroll
            for (int n = 0; n < 2; ++n) bv[bj][n] = bias ? *(const f32x4*)(bias + bcol0 + bj * HALF + 4 * n) : (f32x4){0.f, 0.f, 0.f, 0.f};
#pragma unroll
        for (int ai = 0; ai < 2; ++ai)
#pragma unroll
            for (int m = 0; m < 4; ++m) { bf16_t* rowp = base + (size_t)(row0 + ai * HALF + m * 16) * ldc + col0;
#pragma unroll
                for (int bj = 0; bj < 2; ++bj) { f32x4 v0 = acc[ai][bj][m][0] + bv[bj][0], v1 = acc[ai][bj][m][1] + bv[bj][1];
                    if (ACT == 1) { f32x2 a = gelu_pk((f32x2){v0[0], v0[1]}), b = gelu_pk((f32x2){v0[2], v0[3]}), c = gelu_pk((f32x2){v1[0], v1[1]}), d = gelu_pk((f32x2){v1[2], v1[3]});
                        v0 = (f32x4){a.x, a.y, b.x, b.y}; v1 = (f32x4){c.x, c.y, d.x, d.y}; }
                    v0 = v0 * sc; v1 = v1 * sc; u32x4 w; w.x = cvt_pk_bf16(v0[0], v0[1]); w.y = cvt_pk_bf16(v0[2], v0[3]); w.z = cvt_pk_bf16(v1[0], v1[1]); w.w = cvt_pk_bf16(v1[2], v1[3]);
                    *(u32x4*)(rowp + bj * HALF) = w; } }
    }
};

struct PanelStats {
    unsigned* xbuf;
    unsigned* cnt;
    unsigned* tmo;
    int ntn; float eps;
    unsigned code;
    __device__ __forceinline__ bool run(const f32x4 (&v)[2][2][4][2], const Unit& u, int wr, int wc, int fr, int fq, PG8_LAS unsigned char* lds, int wid, int lane) const {
        typedef float f32x2v __attribute__((ext_vector_type(2)));
        PG8_LAS f32x2v* P = (PG8_LAS f32x2v*)lds;
        PG8_LAS f32x2v* S = (PG8_LAS f32x2v*)(lds + 8192);
        PG8_LAS unsigned* flag = (PG8_LAS unsigned*)(lds + 8192 + 2048);
#pragma unroll
        for (int ai = 0; ai < 2; ++ai)
#pragma unroll
            for (int m = 0; m < 4; ++m) {
                float s = 0.f;
#pragma unroll
                for (int bj = 0; bj < 2; ++bj)
#pragma unroll
                    for (int n = 0; n < 2; ++n) { const f32x4 x = v[ai][bj][m][n]; s += (x[0] + x[1]) + (x[2] + x[3]); }
                s += __shfl_xor(s, 16); s += __shfl_xor(s, 32);
                const float mw = s * (1.0f / 64.0f); float q = 0.f;
#pragma unroll
                for (int bj = 0; bj < 2; ++bj)
#pragma unroll
                    for (int n = 0; n < 2; ++n) { const f32x4 d = v[ai][bj][m][n] - mw; q += (d[0] * d[0] + d[1] * d[1]) + (d[2] * d[2] + d[3] * d[3]); }
                q += __shfl_xor(q, 16); q += __shfl_xor(q, 32);
                if (fq == 0) P[(ai * HALF + wr * 64 + m * 16 + fr) * 4 + wc] = (f32x2v){mw, q};
            }
        asm volatile("s_waitcnt lgkmcnt(0)" ::: "memory"); __builtin_amdgcn_s_barrier(); asm volatile("" ::: "memory");
#if defined(BROKEN_EXCHANGE_NO_WAIT)
#warning BROKEN CONTROL BUILD: the row-statistics exchange does not wait; results are wrong by design
        if (blockIdx.x >= 64) { const long long t0_ = clock64(); while (clock64() - t0_ < 60000) __builtin_amdgcn_s_sleep(8); }
#endif
        const int row = wid * 32 + (lane & 31);
        if (lane < 32) {
            const f32x2v a = P[row * 4 + 0], b = P[row * 4 + 1], c = P[row * 4 + 2], d = P[row * 4 + 3];
            const float mt = (a.x + b.x + c.x + d.x) * 0.25f;
            const float da = a.x - mt, db = b.x - mt, dc = c.x - mt, dd = d.x - mt;
            const float m2 = (a.y + b.y) + (c.y + d.y) + 64.0f * ((da * da + db * db) + (dc * dc + dd * dd));
            unsigned long long* slot = (unsigned long long*)xbuf + ((size_t)(u.pm * BM + row) * 4 + u.pn);
            __hip_atomic_store(slot, ((unsigned long long)__float_as_uint(m2) << 32) | __float_as_uint(mt), __ATOMIC_RELAXED, __HIP_MEMORY_SCOPE_AGENT);
        }
        asm volatile("s_waitcnt vmcnt(0)" ::: "memory");
        if (lane == 0) __hip_atomic_fetch_add(cnt + 64 * u.pm, 1u, __ATOMIC_RELAXED, __HIP_MEMORY_SCOPE_AGENT);
        if (wid == 0) {
            bool dead = false; const unsigned long long t0 = __builtin_amdgcn_s_memrealtime(); const unsigned want = 8u * (unsigned)ntn;
            for (;;) {
#if defined(BROKEN_EXCHANGE_NO_WAIT)
                break;
#endif
                if ((unsigned)__builtin_amdgcn_readfirstlane(__hip_atomic_load(cnt + 64 * u.pm, __ATOMIC_RELAXED, __HIP_MEMORY_SCOPE_AGENT)) >= want) break;
                if (__builtin_amdgcn_s_memrealtime() - t0 > 2000000ull) {
                    if (lane == 0) { unsigned expect = 0u; __hip_atomic_compare_exchange_strong(tmo + 1, &expect, code | (unsigned)(u.pm & 0xff), __ATOMIC_RELAXED, __ATOMIC_RELAXED, __HIP_MEMORY_SCOPE_AGENT);
                                     __hip_atomic_store(tmo, 1u, __ATOMIC_RELAXED, __HIP_MEMORY_SCOPE_AGENT); }
                    dead = true; break; }
                __builtin_amdgcn_s_sleep(2);
            }
            __builtin_amdgcn_fence(__ATOMIC_ACQUIRE, "agent");
            if (lane == 0) flag[0] = dead ? 1u : 0u;
        }
        asm volatile("s_waitcnt vmcnt(0) lgkmcnt(0)" ::: "memory"); __builtin_amdgcn_s_barrier(); asm volatile("" ::: "memory");
        const bool bad = flag[0] != 0u;
        if (lane < 32) {
            const unsigned long long* slot = (const unsigned long long*)xbuf + (size_t)(u.pm * BM + row) * 4; float mt[4], m2[4]; float ms = 0.f;
#pragma unroll
            for (int t = 0; t < 4; ++t) { if (t < ntn) { const unsigned long long w = __hip_atomic_load(slot + t, __ATOMIC_RELAXED, __HIP_MEMORY_SCOPE_AGENT); mt[t] = __uint_as_float((unsigned)w); m2[t] = __uint_as_float((unsigned)(w >> 32)); } else { mt[t] = 0.f; m2[t] = 0.f; } ms += mt[t]; }
            const float mean = ms / (float)ntn; float q = 0.f;
#pragma unroll
            for (int t = 0; t < 4; ++t) if (t < ntn) { const float dm = mt[t] - mean; q += m2[t] + 256.0f * dm * dm; }
            S[row] = (f32x2v){mean, 1.0f / sqrtf(q / (256.0f * (float)ntn) + eps)};
        }
        asm volatile("s_waitcnt lgkmcnt(0)" ::: "memory"); __builtin_amdgcn_s_barrier(); asm volatile("" ::: "memory");
        return bad;
    }
};
struct EpiLnRes {
    static constexpr bool PERM = false, AFTER_DRAIN = true;
    const float* base; float* out; int ldc; const float* bias; PanelStats st; unsigned poison;
    __device__ __forceinline__ void fused(f32x4 (&acc)[2][2][4][2], const Unit& u, int wr, int wc, int fr, int fq, PG8_LAS unsigned char* lds, int wid, int lane) const {
        typedef float f32x2v __attribute__((ext_vector_type(2)));
        const PG8_LAS f32x2v* S = (const PG8_LAS f32x2v*)(lds + 8192);
        const int col0 = u.pn * BM + wc * 32 + 4 * fq;
#pragma unroll
        for (int bj = 0; bj < 2; ++bj)
#pragma unroll
            for (int n = 0; n < 2; ++n) { const f32x4 bv = bias ? *(const f32x4*)(bias + col0 + bj * HALF + n * 16) : (f32x4){0.f, 0.f, 0.f, 0.f};
#pragma unroll
                for (int ai = 0; ai < 2; ++ai)
#pragma unroll
                    for (int m = 0; m < 4; ++m) acc[ai][bj][m][n] += bv; }
        f32x4 pre[4][2][2];
#pragma unroll
        for (int m = 0; m < 4; ++m) { const size_t off = (size_t)(u.pm * BM + wr * 64 + m * 16 + fr) * ldc + col0;
#pragma unroll
            for (int bj = 0; bj < 2; ++bj)
#pragma unroll
                for (int n = 0; n < 2; ++n) pre[m][bj][n] = *(const f32x4*)(base + off + bj * HALF + n * 16); }
        const bool bad = st.run(acc, u, wr, wc, fr, fq, lds, wid, lane) || poison != 0u;
        const float qnan = __builtin_nanf("");
#pragma unroll
        for (int ai = 0; ai < 2; ++ai)
#pragma unroll
            for (int m = 0; m < 4; ++m) { const int r = ai * HALF + wr * 64 + m * 16 + fr; const f32x2v sr = S[r]; const size_t off = (size_t)(u.pm * BM + r) * ldc + col0;
#pragma unroll
                for (int bj = 0; bj < 2; ++bj)
#pragma unroll
                    for (int n = 0; n < 2; ++n) { const f32x4 bs = ai == 0 ? pre[m][bj][n] : *(const f32x4*)(base + off + bj * HALF + n * 16); f32x4 o = bs + (acc[ai][bj][m][n] - sr.x) * sr.y;
                        if (bad) o = (f32x4){qnan, qnan, qnan, qnan}; *(f32x4*)(out + off + bj * HALF + n * 16) = o; }
                if (m & 1) asm volatile("" ::: "memory"); }
    }
};
struct EpiLnResLn {
    static constexpr bool PERM = false, AFTER_DRAIN = true;
    const float* base; float* out; bf16_t* xn; int ldc; const float* bias; PanelStats st1, st2; unsigned poison;
    __device__ __forceinline__ void fused(f32x4 (&acc)[2][2][4][2], const Unit& u, int wr, int wc, int fr, int fq, PG8_LAS unsigned char* lds, int wid, int lane) const {
        typedef float f32x2v __attribute__((ext_vector_type(2))); typedef unsigned u32x2v __attribute__((ext_vector_type(2)));
        const PG8_LAS f32x2v* S = (const PG8_LAS f32x2v*)(lds + 8192);
        const int col0 = u.pn * BM + wc * 32 + 4 * fq;
#pragma unroll
        for (int bj = 0; bj < 2; ++bj)
#pragma unroll
            for (int n = 0; n < 2; ++n) { const f32x4 bv = bias ? *(const f32x4*)(bias + col0 + bj * HALF + n * 16) : (f32x4){0.f, 0.f, 0.f, 0.f};
#pragma unroll
                for (int ai = 0; ai < 2; ++ai)
#pragma unroll
                    for (int m = 0; m < 4; ++m) acc[ai][bj][m][n] += bv; }
        bool bad = st1.run(acc, u, wr, wc, fr, fq, lds, wid, lane) || poison != 0u;
        const float qnan = __builtin_nanf("");
#pragma unroll
        for (int ai = 0; ai < 2; ++ai)
#pragma unroll
            for (int m = 0; m < 4; ++m) { const int r = ai * HALF + wr * 64 + m * 16 + fr; const f32x2v sr = S[r]; const size_t off = (size_t)(u.pm * BM + r) * ldc + col0;
#pragma unroll
                for (int bj = 0; bj < 2; ++bj)
#pragma unroll
                    for (int n = 0; n < 2; ++n) { const f32x4 bs = *(const f32x4*)(base + off + bj * HALF + n * 16); acc[ai][bj][m][n] = bs + (acc[ai][bj][m][n] - sr.x) * sr.y; }
                asm volatile("" : "+v"(acc[ai][0][m][0]), "+v"(acc[ai][0][m][1]), "+v"(acc[ai][1][m][0]), "+v"(acc[ai][1][m][1]));
                if (m & 1) asm volatile("" ::: "memory"); }
        const bool bad1 = bad;
        bad = st2.run(acc, u, wr, wc, fr, fq, lds, wid, lane) || bad;
#pragma unroll
        for (int ai = 0; ai < 2; ++ai)
#pragma unroll
            for (int m = 0; m < 4; ++m) { const int r = ai * HALF + wr * 64 + m * 16 + fr; const f32x2v sr = S[r]; const size_t off = (size_t)(u.pm * BM + r) * ldc + col0;
#pragma unroll
                for (int bj = 0; bj < 2; ++bj)
#pragma unroll
                    for (int n = 0; n < 2; ++n) { const f32x4 x1 = acc[ai][bj][m][n]; *(f32x4*)(out + off + bj * HALF + n * 16) = bad1 ? (f32x4){qnan, qnan, qnan, qnan} : x1;
                        const f32x4 o = (x1 - sr.x) * sr.y; u32x2v w; w.x = cvt_pk_bf16(o[0], o[1]); w.y = cvt_pk_bf16(o[2], o[3]);
                        if (bad) { w.x = 0x7fc07fc0u; w.y = 0x7fc07fc0u; } *(u32x2v*)(xn + off + bj * HALF + n * 16) = w; }
                asm volatile("" ::: "memory"); }
    }
};

template <class Epi, class Sched, bool ALIGN_EPI = false, bool SP2 = false>
__device__ __forceinline__ void gemm_phase(PG8_LAS unsigned char* lds, const Gemm g, const Sched& S, const Epi& E) {
    const int tid = threadIdx.x, wid = __builtin_amdgcn_readfirstlane(tid >> 6), lane = tid & 63, wr = wid >> 2, wc = wid & 3, fr = lane & 15, fq = lane >> 4;
    const int K = g.K, nt = K / BK;
    unsigned voffA[2], voffB[2];
#pragma unroll
    for (int i = 0; i < 2; ++i) { int R, C; stage_rc(tid * 16 + i * 8192, R, C); const int Rb = Epi::PERM ? ((R & ~31) + perm32(R & 31)) : R;
        voffA[i] = (unsigned)(R * K + C) * 2u; voffB[i] = (unsigned)(Rb * K + C) * 2u; }
    const size_t kstep = (size_t)(BK * 2);
    const size_t hstep = (size_t)HALF * K * 2;
    const size_t tstep = 2 * hstep;
    const unsigned ldsw = (unsigned)wid * 1024u;
    const int aoff = lds_byte(wr * 64 + fr, fq * 8), boff = lds_byte(wc * 32 + fr, fq * 8);
#define PG8_SA(b, h) (((b) * 2 + (h)) * HTB)
#define PG8_SB(b, h) ((4 + (b) * 2 + (h)) * HTB)
#define PG8_STAGE(bufoff, gbase, voff) do { _Pragma("unroll") for (int _i = 0; _i < 2; ++_i) \
        __builtin_amdgcn_global_load_lds((const unsigned*)((const char*)(gbase) + (voff)[_i]), (PG8_LAS unsigned*)(lds + (bufoff) + ldsw + _i * 8192), 16, 0, 0); } while (0)
#define PG8_LDA(dst, b, h) do { _Pragma("unroll") for (int m = 0; m < 4; ++m) _Pragma("unroll") for (int k = 0; k < 2; ++k) dst[m][k] = *(const PG8_LAS bf16x8*)(lds + PG8_SA(b, h) + aoff + m * 2048 + k * 1024); } while (0)
#define PG8_LDB(dst, b, h) do { _Pragma("unroll") for (int n = 0; n < 2; ++n) _Pragma("unroll") for (int k = 0; k < 2; ++k) dst[n][k] = *(const PG8_LAS bf16x8*)(lds + PG8_SB(b, h) + boff + n * 2048 + k * 1024); } while (0)
#define PG8_MMA(ai, bj, At, Bt) do { __builtin_amdgcn_s_setprio(1); _Pragma("unroll") for (int m = 0; m < 4; ++m) _Pragma("unroll") for (int n = 0; n < 2; ++n) _Pragma("unroll") for (int k = 0; k < 2; ++k) \
        acc[ai][bj][m][n] = __builtin_amdgcn_mfma_f32_16x16x32_bf16(Bt[n][k], At[m][k], acc[ai][bj][m][n], 0, 0, 0); __builtin_amdgcn_s_setprio(0); } while (0)
#define PG8_WAIT_V(n) asm volatile("s_waitcnt vmcnt(" #n ")" ::: "memory")
#define PG8_WAIT_L(n) asm volatile("s_waitcnt lgkmcnt(" #n ")" ::: "memory")
#define PG8_BAR __builtin_amdgcn_s_barrier()
#define PG8_SCHED __builtin_amdgcn_sched_barrier(0)
    Unit cur, nxt; int ui = 0;
    if (!S.next(0, cur)) return;
    f32x4 acc[2][2][4][2];
#pragma unroll
    for (int a = 0; a < 2; ++a)
#pragma unroll
        for (int b = 0; b < 2; ++b)
#pragma unroll
            for (int m = 0; m < 4; ++m)
#pragma unroll
                for (int n = 0; n < 2; ++n) acc[a][b][m][n] = (f32x4){0.f, 0.f, 0.f, 0.f};
    bf16x8 At[4][2], B0[2][2], B1[2][2];
    const char* cA = (const char*)g.A + (size_t)cur.pm * tstep; const char* cB = (const char*)g.Bt + (size_t)cur.pn * tstep;
    S.a_ready(cur);
    if constexpr (SP2) {
        PG8_STAGE(PG8_SB(0, 0), cB, voffB); PG8_STAGE(PG8_SB(0, 1), cB + hstep, voffB); PG8_STAGE(PG8_SA(0, 0), cA, voffA); PG8_STAGE(PG8_SA(0, 1), cA + hstep, voffA);
        if (wr == 1) PG8_BAR;
        PG8_WAIT_V(2); PG8_BAR;
        PG8_STAGE(PG8_SB(1, 0), cB + kstep, voffB); PG8_STAGE(PG8_SA(1, 0), cA + kstep, voffA); PG8_STAGE(PG8_SB(1, 1), cB + hstep + kstep, voffB);
        PG8_WAIT_V(6); PG8_BAR;
    } else {
        PG8_STAGE(PG8_SB(0, 0), cB, voffB); PG8_STAGE(PG8_SA(0, 0), cA, voffA); PG8_STAGE(PG8_SB(0, 1), cB + hstep, voffB); PG8_STAGE(PG8_SA(0, 1), cA + hstep, voffA);
        if (wr == 1) PG8_BAR;
        PG8_WAIT_V(4); PG8_BAR;
        PG8_STAGE(PG8_SB(1, 0), cB + kstep, voffB); PG8_STAGE(PG8_SA(1, 0), cA + kstep, voffA); PG8_STAGE(PG8_SB(1, 1), cB + hstep + kstep, voffB);
        PG8_WAIT_V(6); PG8_BAR;
    }
    for (;;) {
        const bool has_next = S.next(ui + 1, nxt);
        const char* nA = has_next ? (const char*)g.A + (size_t)nxt.pm * tstep : cA; const char* nB = has_next ? (const char*)g.Bt + (size_t)nxt.pn * tstep : cB;
        for (int t = 0; t < nt; t += 2) {
            const bool last = (t == nt - 2);
            const char* a1 = cA + (size_t)(t + 1) * kstep;
            const char* a2 = last ? nA : cA + (size_t)(t + 2) * kstep; const char* b2 = last ? nB : cB + (size_t)(t + 2) * kstep;
            const char* a3 = a2 + kstep; const char* b3 = b2 + kstep;
            if (last && has_next) S.a_ready(nxt);
            if constexpr (SP2) {
            PG8_LDB(B0, 0, 0); PG8_LDB(B1, 0, 1); PG8_SCHED; PG8_LDA(At, 0, 0); PG8_STAGE(PG8_SA(1, 1), a1 + hstep, voffA);
            PG8_WAIT_V(8); PG8_WAIT_L(0); PG8_BAR; PG8_MMA(0, 0, At, B0); PG8_MMA(0, 1, At, B1); PG8_BAR; PG8_SCHED;
            PG8_LDA(At, 0, 1); PG8_STAGE(PG8_SB(0, 0), b2, voffB); PG8_STAGE(PG8_SB(0, 1), b2 + hstep, voffB); PG8_STAGE(PG8_SA(0, 0), a2, voffA);
            PG8_WAIT_V(8); PG8_WAIT_L(0); PG8_BAR; PG8_MMA(1, 0, At, B0); PG8_MMA(1, 1, At, B1); PG8_BAR; PG8_SCHED;
            PG8_LDB(B0, 1, 0); PG8_LDB(B1, 1, 1); PG8_SCHED; PG8_LDA(At, 1, 0); PG8_STAGE(PG8_SA(0, 1), a2 + hstep, voffA);
            PG8_WAIT_V(8); PG8_WAIT_L(0); PG8_BAR; PG8_MMA(0, 0, At, B0); PG8_MMA(0, 1, At, B1); PG8_BAR; PG8_SCHED;
            PG8_LDA(At, 1, 1); PG8_STAGE(PG8_SB(1, 0), b3, voffB); PG8_STAGE(PG8_SB(1, 1), b3 + hstep, voffB); PG8_STAGE(PG8_SA(1, 0), a3, voffA);
            PG8_WAIT_V(8); PG8_WAIT_L(0); PG8_BAR; PG8_MMA(1, 0, At, B0); PG8_MMA(1, 1, At, B1); PG8_BAR; PG8_SCHED;
            } else {
            PG8_LDB(B0, 0, 0); PG8_SCHED; PG8_LDA(At, 0, 0); PG8_STAGE(PG8_SA(1, 1), a1 + hstep, voffA);
            PG8_WAIT_L(8); PG8_BAR; PG8_WAIT_L(0); PG8_MMA(0, 0, At, B0); PG8_BAR; PG8_SCHED;
            PG8_LDB(B1, 0, 1); PG8_STAGE(PG8_SB(0, 0), b2, voffB);
            PG8_BAR; PG8_WAIT_L(0); PG8_MMA(0, 1, At, B1); PG8_BAR;
            PG8_LDA(At, 0, 1); PG8_STAGE(PG8_SA(0, 0), a2, voffA);
            PG8_BAR; PG8_WAIT_L(0); PG8_MMA(1, 0, At, B0); PG8_BAR; PG8_SCHED;
            PG8_STAGE(PG8_SB(0, 1), b2 + hstep, voffB);
            PG8_WAIT_V(6); PG8_BAR; PG8_MMA(1, 1, At, B1); PG8_BAR;
            PG8_LDB(B0, 1, 0); PG8_SCHED; PG8_LDA(At, 1, 0); PG8_STAGE(PG8_SA(0, 1), a2 + hstep, voffA);
            PG8_WAIT_L(8); PG8_BAR; PG8_WAIT_L(0); PG8_MMA(0, 0, At, B0); PG8_BAR; PG8_SCHED;
            PG8_LDB(B1, 1, 1); PG8_STAGE(PG8_SB(1, 0), b3, voffB);
            PG8_BAR; PG8_WAIT_L(0); PG8_MMA(0, 1, At, B1); PG8_BAR;
            PG8_LDA(At, 1, 1); PG8_STAGE(PG8_SA(1, 0), a3, voffA);
            PG8_BAR; PG8_WAIT_L(0); PG8_MMA(1, 0, At, B0); PG8_BAR; PG8_SCHED;
            PG8_STAGE(PG8_SB(1, 1), b3 + hstep, voffB);
            PG8_WAIT_V(6); PG8_BAR; PG8_MMA(1, 1, At, B1); PG8_BAR;
            }
        }
        if constexpr (ALIGN_EPI) { if (wr == 0) PG8_BAR; }
        if constexpr (!Epi::AFTER_DRAIN) { E(acc, cur, wr, wc, fr, fq); S.done(cur); }
        if (!has_next) break;
#pragma unroll
        for (int a = 0; a < 2; ++a)
#pragma unroll
            for (int b = 0; b < 2; ++b)
#pragma unroll
                for (int m = 0; m < 4; ++m)
#pragma unroll
                    for (int n = 0; n < 2; ++n) acc[a][b][m][n] = (f32x4){0.f, 0.f, 0.f, 0.f};
        cur = nxt; cA = nA; cB = nB; ++ui;
        if constexpr (ALIGN_EPI) { if (wr == 1) PG8_BAR; }
    }
    PG8_WAIT_V(0);
    if constexpr (!ALIGN_EPI) { if (wr == 0) PG8_BAR; }
    PG8_BAR;
    if constexpr (Epi::AFTER_DRAIN) { E.fused(acc, cur, wr, wc, fr, fq, lds, wid, lane); S.done(cur); }
#undef PG8_SA
#undef PG8_SB
#undef PG8_STAGE
#undef PG8_LDA
#undef PG8_LDB
#undef PG8_MMA
#undef PG8_WAIT_V
#undef PG8_WAIT_L
#undef PG8_BAR
#undef PG8_SCHED
}
}
#define GAS __attribute__((address_space(1)))
#define LAS __attribute__((address_space(3)))
typedef unsigned short bf16;
typedef unsigned v4u __attribute__((ext_vector_type(4)));
typedef float f32x4 __attribute__((ext_vector_type(4)));
typedef short bf16x8 __attribute__((ext_vector_type(8)));
typedef GAS unsigned gu32;
typedef GAS unsigned long long gu64;
#define RLX_AGENT __ATOMIC_RELAXED, __HIP_MEMORY_SCOPE_AGENT
#define LDS_WAIT() asm volatile("s_waitcnt lgkmcnt(0)" ::: "memory")
#define VM_WAIT() asm volatile("s_waitcnt vmcnt(0)" ::: "memory")
__device__ __forceinline__ unsigned long long rt() { return __builtin_amdgcn_s_memrealtime(); }
__device__ __forceinline__ unsigned f2bf(float f) { unsigned u = __builtin_bit_cast(unsigned, f); return (u + 0x7fffu + ((u >> 16) & 1u)) >> 16; }
__device__ __forceinline__ unsigned pk2(float lo, float hi) { return f2bf(lo) | (f2bf(hi) << 16); }

#define XB_TMO      128
#define XB_XCNT(j)  (256  + 64 * (j))
#define XB_XSUB(j)  (1280 + 64 * (j))
#define XB_XGEN(j)  (2304 + 64 * (j))
#define XB_TOP      3328
#define XB_TOPGEN   3392
#define XCD_BAR_WORDS 3456
#define XB_SPIN_CAP (1u << 22)

__device__ __forceinline__ unsigned xb_ld(unsigned* p)              { return __hip_atomic_load(p, __ATOMIC_RELAXED, __HIP_MEMORY_SCOPE_AGENT); }
__device__ __forceinline__ unsigned xb_add(unsigned* p, unsigned v) { return __hip_atomic_fetch_add(p, v, __ATOMIC_RELAXED, __HIP_MEMORY_SCOPE_AGENT); }
__device__ __forceinline__ unsigned xb_xcc_id() { return (unsigned)__builtin_amdgcn_s_getreg((3 << 11) | 20) & 0xFu; }
#define XB_SPIN(cond, bar) do { unsigned _sp = 0; while (cond) { __builtin_amdgcn_s_sleep(1); \
    if ((++_sp & 255u) == 0u) { if (xb_ld(&(bar)[XB_TMO])) break; if (_sp > XB_SPIN_CAP) { atomicAdd(&(bar)[XB_TMO], 1u); break; } } } } while (0)

struct XcdBarrier {
    unsigned* bar; unsigned x;
    volatile LAS unsigned* st;
};

__device__ __forceinline__ XcdBarrier xcd_barrier_post(unsigned* bar, volatile LAS unsigned* st) {
    XcdBarrier b; b.bar = bar; b.x = xb_xcc_id(); b.st = st;
    if (threadIdx.x == 0) (void)xb_add(&bar[XB_XCNT(b.x)], 1u);
    return b;
}
__device__ __forceinline__ void xcd_barrier_complete(unsigned* bar, unsigned x, unsigned& nloc, unsigned& nx) {
    const unsigned G = gridDim.x * gridDim.y * gridDim.z;
    unsigned sum, cnt, mine, sp = 0u;
    for (;;) {
        sum = 0u; cnt = 0u; mine = 0u;
#pragma unroll
        for (unsigned j = 0; j < 16; ++j) { const unsigned c = xb_ld(&bar[XB_XCNT(j)]); sum += c; cnt += (c > 0u) ? 1u : 0u; mine = (j == x) ? c : mine; }
        if (sum == G) break;
        __builtin_amdgcn_s_sleep(1);
        if ((++sp & 255u) == 0u) { if (xb_ld(&bar[XB_TMO])) break; if (sp > XB_SPIN_CAP) { atomicAdd(&bar[XB_TMO], 1u); break; } }
    }
    nloc = mine > 0u ? mine : 1u; nx = cnt > 0u ? cnt : 1u;
}

__device__ __forceinline__ void xcd_barrier(const XcdBarrier& b) {
    asm volatile("s_waitcnt vmcnt(0)" ::: "memory");
    __syncthreads();
    if (threadIdx.x == 0) {
        unsigned* bar = b.bar;
        __builtin_amdgcn_s_waitcnt(0);
        unsigned nloc = b.st[0], nx = b.st[1];
        if (nloc == 0u) { xcd_barrier_complete(bar, b.x, nloc, nx); b.st[0] = nloc; b.st[1] = nx; }
        const unsigned old = xb_add(&bar[XB_XSUB(b.x)], 1u);
        const unsigned gen = old / nloc;
        if (old + 1u == (gen + 1u) * nloc) {
            __builtin_amdgcn_fence(__ATOMIC_RELEASE, "agent");
            asm volatile("s_waitcnt vmcnt(0)" ::: "memory");
            const unsigned og = xb_add(&bar[XB_TOP], 1u);
            const unsigned tg = og / nx;
            if (og + 1u == (tg + 1u) * nx) xb_add(&bar[XB_TOPGEN], 1u);
            else XB_SPIN(xb_ld(&bar[XB_TOPGEN]) == tg, bar);
            __builtin_amdgcn_fence(__ATOMIC_ACQUIRE, "agent");
            xb_add(&bar[XB_XGEN(b.x)], 1u);
            asm volatile("s_waitcnt vmcnt(0)" ::: "memory");
        } else {
            XB_SPIN(xb_ld(&bar[XB_XGEN(b.x)]) == gen, bar);
            __builtin_amdgcn_fence(__ATOMIC_ACQUIRE, "agent");
            asm volatile("s_waitcnt vmcnt(0)" ::: "memory");
        }
    }
    __syncthreads();
}

namespace fox {
using bf16 = __hip_bfloat16;
using bf16x8 = __attribute__((ext_vector_type(8))) short;
using s16x4 = __attribute__((ext_vector_type(4))) short;
using f32x16 = __attribute__((ext_vector_type(16))) float;
using u32x4 = __attribute__((ext_vector_type(4))) unsigned;
using f32x4v = __attribute__((ext_vector_type(4))) float;
constexpr int BATCH = 16, NHEAD = 8, SEQ = 2048, D = 64, DM = NHEAD * D;
constexpr int NW = 8, QBLK = 32, QB = QBLK * NW, KVBLK = 64, NQB = SEQ / QB;
constexpr float C2 = 0.125f * 1.4426950408889634f;
constexpr int SLOTB = 8192, LDS_K = 0, LDS_V = 3 * SLOTB, LDS_WS = 6 * SLOTB, LDS_OST = LDS_WS + NW * 256, LDS_CB = LDS_OST + NW * 4096, LDS_BYTES = LDS_CB + SEQ * 4;
#define SBAR() __builtin_amdgcn_sched_barrier(0)
#define PIN(x) asm volatile("" : "+v"(x))
#define MFMA(a, b, c) __builtin_amdgcn_mfma_f32_32x32x16_bf16(a, b, c, 0, 0, 0)
#define WAIT_BAR(N) asm volatile("s_waitcnt vmcnt(" #N ") lgkmcnt(0)\n\ts_barrier" ::: "memory")

__device__ __forceinline__ int crow(int r, int hi) { return (r & 3) + 8 * (r >> 2) + 4 * hi; }
__device__ __forceinline__ unsigned cvtpk(float lo, float hi) { unsigned r; asm("v_cvt_pk_bf16_f32 %0, %1, %2" : "=v"(r) : "v"(lo), "v"(hi)); return r; }
__device__ __forceinline__ void glds16(const void* g, unsigned lds_base) {
    unsigned sv; asm volatile("s_mov_b32 %0, m0\n\ts_mov_b32 m0, %2\n\ts_nop 0\n\tglobal_load_lds_dwordx4 %1, off\n\ts_mov_b32 m0, %0" : "=&s"(sv) : "v"(g), "s"(lds_base) : "memory"); }
typedef __attribute__((address_space(3))) const char* lds_cptr;
typedef short v4i16_t __attribute__((ext_vector_type(4)));
__device__ __forceinline__ void kload2(bf16x8* kf, lds_cptr kp, int d0) { kf[2 * d0] = *(const __attribute__((address_space(3))) bf16x8*)(kp + d0 * 2048); kf[2 * d0 + 1] = *(const __attribute__((address_space(3))) bf16x8*)(kp + d0 * 2048 + 512); }
__device__ __forceinline__ s16x4 vtr(lds_cptr p) { return __builtin_bit_cast(s16x4, __builtin_amdgcn_ds_read_tr16_b64_v4i16((__attribute__((address_space(3))) v4i16_t*)p)); }
#define MX3(a, b, c) __builtin_fmaxf(__builtin_fmaxf((a), (b)), (c))
__device__ __forceinline__ float rowmax(const f32x16& p0, const f32x16& p1) {
    float a = MX3(p0[0], p0[1], p1[0]), b = MX3(p0[2], p0[3], p1[1]); a = MX3(a, p1[2], p1[3]);
#pragma unroll
    for (int r = 4; r < 16; r += 4) { a = MX3(a, p0[r], p0[r + 1]); b = MX3(b, p0[r + 2], p0[r + 3]); a = MX3(a, p1[r], p1[r + 1]); b = MX3(b, p1[r + 2], p1[r + 3]); }
    float m = __builtin_fmaxf(a, b); auto rr = __builtin_amdgcn_permlane32_swap(__float_as_uint(m), __float_as_uint(m), false, false);
    return __builtin_fmaxf(__uint_as_float(rr[0]), __uint_as_float(rr[1])); }
__device__ __forceinline__ void cmask(f32x16& p0, f32x16& p1, int jb, int qrel, int hi) {
    const int kb = 64 * jb + 4 * hi;
#pragma unroll
    for (int r = 0; r < 16; ++r) { const int kv = kb + (r & 3) + 8 * (r >> 2); if (kv > qrel) p0[r] = -INFINITY; if (kv + 32 > qrel) p1[r] = -INFINITY; } }

__device__ __forceinline__ void attn64_unit(int b, int h, int qb, const bf16* Q, const bf16* __restrict__ K, const bf16* __restrict__ V, bf16* O, const float* __restrict__ CBg, char* lds) {
    const int tid = threadIdx.x, lane = tid & 63, r32 = lane & 31, hi = lane >> 5; const int wid = __builtin_amdgcn_readfirstlane(tid >> 6);
    const long rowbase = (long)b * SEQ; const int q0 = qb * QB, NT = (q0 + QB) / KVBLK;
    const bf16* Qw = Q + (rowbase + q0 + wid * QBLK) * DM + h * D;
    const unsigned lds0 = (unsigned)(uintptr_t)lds; float* wsf = (float*)(lds + LDS_WS) + wid * 64;
    const bf16* ksrc = K + rowbase * DM + h * D + (long)lane * DM + wid * 8;
    const bf16* vsrc = V + rowbase * DM + h * D + (long)(16 * (wid & 3) + (lane >> 2)) * DM + (wid >> 2) * 32 + (lane & 3) * 8;
    const unsigned kdst = lds0 + LDS_K + wid * 1024, vdst = lds0 + LDS_V + wid * 1024;
#define DMA_K(t, slot) glds16(ksrc + (long)(t) * KVBLK * DM, (unsigned)__builtin_amdgcn_readfirstlane(kdst + (slot)))
#define DMA_V(t, slot) glds16(vsrc + (long)(t) * KVBLK * DM, (unsigned)__builtin_amdgcn_readfirstlane(vdst + (slot)))
    const lds_cptr vp0 = (lds_cptr)lds + LDS_V + ((lane >> 4) & 1) * 32 + (lane & 3) * 8 + (4 * hi + ((lane & 15) >> 2)) * 64;
    const lds_cptr kp0 = (lds_cptr)lds + LDS_K + hi * 1024 + r32 * 16;
    const bool cb_mine = (4 * tid < NT * KVBLK); f32x4v cbv = (f32x4v){0.f, 0.f, 0.f, 0.f};
    if (cb_mine) cbv = *(const f32x4v*)(CBg + (long)(b * NHEAD + h) * SEQ + 4 * tid);
    DMA_K(0, 0); DMA_V(0, 0); DMA_K(1, SLOTB);
    bf16x8 qr[4];
#pragma unroll
    for (int d0 = 0; d0 < 4; ++d0) qr[d0] = *reinterpret_cast<const bf16x8*>(&Qw[(long)r32 * DM + d0 * 16 + hi * 8]);
    float mhat = 0.f, l_reg = 0.f; f32x16 o[2]; o[0] = f32x16{}; o[1] = f32x16{};
    const lds_cptr cbp0 = (lds_cptr)lds + LDS_CB + hi * 16;
#define LDBIAS(P0_, P1_, t_) do { const lds_cptr cq_ = cbp0 + (t_) * 256; _Pragma("unroll") for (int g_ = 0; g_ < 4; ++g_) { \
        const f32x4v a_ = *(const __attribute__((address_space(3))) f32x4v*)(cq_ + g_ * 32), b_ = *(const __attribute__((address_space(3))) f32x4v*)(cq_ + 128 + g_ * 32); \
        P0_[4 * g_] = a_[0]; P0_[4 * g_ + 1] = a_[1]; P0_[4 * g_ + 2] = a_[2]; P0_[4 * g_ + 3] = a_[3]; P1_[4 * g_] = b_[0]; P1_[4 * g_ + 1] = b_[1]; P1_[4 * g_ + 2] = b_[2]; P1_[4 * g_ + 3] = b_[3]; } } while (0)
#define LDBIAS2(G_, P0_, P1_, t_, g_) do { if (G_) { const lds_cptr cq_ = cbp0 + (t_) * 256; \
        const f32x4v a_ = *(const __attribute__((address_space(3))) f32x4v*)(cq_ + (g_) * 32), b_ = *(const __attribute__((address_space(3))) f32x4v*)(cq_ + 128 + (g_) * 32); \
        P0_[4 * (g_)] = a_[0]; P0_[4 * (g_) + 1] = a_[1]; P0_[4 * (g_) + 2] = a_[2]; P0_[4 * (g_) + 3] = a_[3]; P1_[4 * (g_)] = b_[0]; P1_[4 * (g_) + 1] = b_[1]; P1_[4 * (g_) + 2] = b_[2]; P1_[4 * (g_) + 3] = b_[3]; SBAR(); } } while (0)
    const int qrel = wid * QBLK + r32; bool resc = false;
    f32x16 pA0, pA1, pB0, pB1; bf16x8 kf[8]; s16x4 vlo[8], vhi[8]; u32x4 pw0, pw1, pw2, pw3;
    int sl_prev = 0, sl_cur = 0, sl_next = SLOTB;
#define ROT() do { sl_prev = sl_cur; sl_cur = sl_next; sl_next = (sl_next == 2 * SLOTB) ? 0 : sl_next + SLOTB; } while (0)
#define EX(v) __builtin_amdgcn_exp2f(__builtin_fmaf((v), C2, nmh))
#define RESC() do { if (resc) { _Pragma("unroll") for (int d_ = 0; d_ < 2; ++d_) _Pragma("unroll") for (int r = 0; r < 16; ++r) o[d_][r] *= wsf[crow(r, hi)]; } } while (0)
    DMA_K(2, 2 * SLOTB);
    if (cb_mine) *(__attribute__((address_space(3))) f32x4v*)((lds_cptr)lds + LDS_CB + 16 * tid) = cbv;
    WAIT_BAR(3);
    _Pragma("unroll") for (int d0 = 0; d0 < 4; ++d0) kload2(kf, kp0, d0);
    LDBIAS(pA0, pA1, 0);
    pA0 = MFMA(kf[0], qr[0], pA0); pA1 = MFMA(kf[1], qr[0], pA1); pA0 = MFMA(kf[2], qr[1], pA0); pA1 = MFMA(kf[3], qr[1], pA1);
    pA0 = MFMA(kf[4], qr[2], pA0); pA1 = MFMA(kf[5], qr[2], pA1); pA0 = MFMA(kf[6], qr[3], pA0); pA1 = MFMA(kf[7], qr[3], pA1);
    if (NT == 4) cmask(pA0, pA1, 0, qrel, hi);
    { const float rm = rowmax(pA0, pA1); mhat = rm * C2; const float nmh = -mhat;
#pragma unroll
      for (int r = 0; r < 16; ++r) { pA0[r] = EX(pA0[r]); pA1[r] = EX(pA1[r]); } }
    WAIT_BAR(0);
    DMA_K(3, 0); DMA_V(1, SLOTB); ROT();
    _Pragma("unroll") for (int d0 = 0; d0 < 4; ++d0) kload2(kf, kp0 + sl_cur, d0);
    LDBIAS(pB0, pB1, 1);
    WAIT_BAR(2);
#define PKW(P, i) cvtpk(P[i], P[i + 1])
#define PAF(k) __builtin_bit_cast(bf16x8, pw##k)
#define VFR(i) (bf16x8){vlo[i][0], vlo[i][1], vlo[i][2], vlo[i][3], vhi[i][0], vhi[i][1], vhi[i][2], vhi[i][3]}
#define VRD(i) do { vlo[i] = vtr(vp_ + (((i) >> 2) * 4096 + ((i) & 3) * 1024)); vhi[i] = vtr(vp_ + (((i) >> 2) * 4096 + ((i) & 3) * 1024 + 512)); } while (0)
#define KRD(G, d0) do { if (G) { kload2(kf, kp0 + sl_next, d0); SBAR(); } } while (0)
#define GAPA(MF, a0, a1, a2, a3, W0, W1, PW) do { MF; sacc += a0; sacc += a1; sacc += a2; sacc += a3; W0; W1; PIN(PW); PIN(sacc); SBAR(); } while (0)
#define GAPB(MF, X, i) do { MF; X[i] = EX(X[i]); X[i + 1] = EX(X[i + 1]); X[i + 2] = EX(X[i + 2]); X[i + 3] = EX(X[i + 3]); PIN(X); SBAR(); } while (0)
#define STEP(C0, C1, P0, P1, t, MASK, GK, GV, GL) do { SBAR(); \
    const lds_cptr vp_ = vp0 + sl_prev; \
    VRD(0); SBAR(); float sacc = P0[0] + P0[1];                                                                                                       \
                    GAPA(C0 = MFMA(kf[0], qr[0], C0), P0[2], P0[3], P0[4], P0[5],     pw0[0] = PKW(P0, 0),  pw0[1] = PKW(P0, 2),  pw0); \
    VRD(4); SBAR(); GAPA(C1 = MFMA(kf[1], qr[0], C1), P0[6], P0[7], P0[8], P0[9],     pw0[2] = PKW(P0, 4),  pw0[3] = PKW(P0, 6),  pw0); \
    VRD(1); SBAR(); GAPA(C0 = MFMA(kf[2], qr[1], C0),    P0[10], P0[11], P0[12], P0[13], pw1[0] = PKW(P0, 8),  pw1[1] = PKW(P0, 10), pw1); \
    VRD(5); SBAR(); GAPA(C1 = MFMA(kf[3], qr[1], C1),    P0[14], P0[15], P1[0], P1[1],   pw1[2] = PKW(P0, 12), pw1[3] = PKW(P0, 14), pw1); \
    VRD(2); SBAR(); GAPA(C0 = MFMA(kf[4], qr[2], C0),    P1[2], P1[3], P1[4], P1[5],     pw2[0] = PKW(P1, 0),  pw2[1] = PKW(P1, 2),  pw2); \
    VRD(6); SBAR(); GAPA(C1 = MFMA(kf[5], qr[2], C1),    P1[6], P1[7], P1[8], P1[9],     pw2[2] = PKW(P1, 4),  pw2[3] = PKW(P1, 6),  pw2); \
    VRD(3); SBAR(); GAPA(C0 = MFMA(kf[6], qr[3], C0),    P1[10], P1[11], P1[12], P1[13], pw3[0] = PKW(P1, 8),  pw3[1] = PKW(P1, 10), pw3); \
    VRD(7); SBAR(); GAPA(C1 = MFMA(kf[7], qr[3], C1),    P1[14], P1[15], 0.f, 0.f,       pw3[2] = PKW(P1, 12), pw3[3] = PKW(P1, 14), pw3); \
    l_reg += sacc; \
    if (GK) DMA_K((t) + 3, sl_cur); if (GV) DMA_V((t) + 1, sl_next);                                                       \
    if (MASK) cmask(C0, C1, (t) - (NT - 4), qrel, hi); \
    { const float rm = __builtin_fmaf(rowmax(C0, C1), C2, -mhat); resc = false;                                            \
      if (__builtin_expect(__any(rm > 8.0f), 0)) { const float dl = __builtin_fmaxf(rm, 0.f); mhat += dl;     \
          const float f = __builtin_amdgcn_exp2f(-dl); l_reg *= f; if (hi == 0) wsf[r32] = f; resc = true; } } \
    const float nmh = -mhat; SBAR(); \
    LDBIAS2(GL, P0, P1, (t) + 1, 0); GAPB(o[0] = MFMA(PAF(0), VFR(0), o[0]), C0, 0);   LDBIAS2(GL, P0, P1, (t) + 1, 1); GAPB(o[1] = MFMA(PAF(0), VFR(4), o[1]), C0, 4); \
    KRD(GL, 0); GAPB(o[0] = MFMA(PAF(1), VFR(1), o[0]), C0, 8);  KRD(GL, 1); GAPB(o[1] = MFMA(PAF(1), VFR(5), o[1]), C0, 12);                                     \
    KRD(GL, 2); GAPB(o[0] = MFMA(PAF(2), VFR(2), o[0]), C1, 0);  KRD(GL, 3); GAPB(o[1] = MFMA(PAF(2), VFR(6), o[1]), C1, 4); \
    LDBIAS2(GL, P0, P1, (t) + 1, 2); GAPB(o[0] = MFMA(PAF(3), VFR(3), o[0]), C1, 8);   LDBIAS2(GL, P0, P1, (t) + 1, 3); GAPB(o[1] = MFMA(PAF(3), VFR(7), o[1]), C1, 12); \
    } while (0)
    int t = 1;
    for (; t + 5 < NT; t += 2) {
        STEP(pB0, pB1, pA0, pA1, t, false, true, true, true);     WAIT_BAR(2); RESC(); ROT();
        STEP(pA0, pA1, pB0, pB1, t + 1, false, true, true, true); WAIT_BAR(2); RESC(); ROT();
    }
#define ENDW(tt) do { if ((tt) + 3 < NT) { WAIT_BAR(2); } else if ((tt) + 2 < NT) { WAIT_BAR(1); } else { WAIT_BAR(0); } } while (0)
    for (; t + 1 < NT; t += 2) {
        STEP(pB0, pB1, pA0, pA1, t, true, (t + 3 < NT), (t + 1 < NT), (t + 1 < NT));         ENDW(t);     RESC(); ROT();
        STEP(pA0, pA1, pB0, pB1, t + 1, true, (t + 4 < NT), (t + 2 < NT), (t + 2 < NT));     ENDW(t + 1); RESC(); ROT();
    }
    STEP(pB0, pB1, pA0, pA1, NT - 1, true, false, false, false); RESC();
    { float sacc = pB0[0] + pB0[1];
#pragma unroll
      for (int r = 2; r < 16; ++r) sacc += pB0[r];
#pragma unroll
      for (int r = 0; r < 16; ++r) sacc += pB1[r];
      l_reg += sacc;
      pw0 = (u32x4){PKW(pB0, 0), PKW(pB0, 2), PKW(pB0, 4), PKW(pB0, 6)}; pw1 = (u32x4){PKW(pB0, 8), PKW(pB0, 10), PKW(pB0, 12), PKW(pB0, 14)};
      pw2 = (u32x4){PKW(pB1, 0), PKW(pB1, 2), PKW(pB1, 4), PKW(pB1, 6)}; pw3 = (u32x4){PKW(pB1, 8), PKW(pB1, 10), PKW(pB1, 12), PKW(pB1, 14)};
      const lds_cptr vp_ = vp0 + sl_cur; _Pragma("unroll") for (int i = 0; i < 8; ++i) VRD(i);
      o[0] = MFMA(PAF(0), VFR(0), o[0]); o[1] = MFMA(PAF(0), VFR(4), o[1]); o[0] = MFMA(PAF(1), VFR(1), o[0]); o[1] = MFMA(PAF(1), VFR(5), o[1]);
      o[0] = MFMA(PAF(2), VFR(2), o[0]); o[1] = MFMA(PAF(2), VFR(6), o[1]); o[0] = MFMA(PAF(3), VFR(3), o[0]); o[1] = MFMA(PAF(3), VFR(7), o[1]); }
    { auto rr = __builtin_amdgcn_permlane32_swap(__float_as_uint(l_reg), __float_as_uint(l_reg), false, false); l_reg = __uint_as_float(rr[0]) + __uint_as_float(rr[1]); }
    if (hi == 0) wsf[32 + r32] = l_reg; asm volatile("s_waitcnt lgkmcnt(0)" ::: "memory");
    float rli[16];
#pragma unroll
    for (int r = 0; r < 16; ++r) rli[r] = __builtin_amdgcn_rcpf(wsf[32 + crow(r, hi)]);
    bf16* Ow = O + (rowbase + q0 + wid * QBLK) * DM + h * D; bf16* stg = (bf16*)(lds + LDS_OST) + wid * 2048;
#pragma unroll
    for (int r = 0; r < 16; ++r) { const int orow = crow(r, hi);
#pragma unroll
        for (int d0 = 0; d0 < 2; ++d0) stg[orow * 64 + d0 * 32 + r32] = __float2bfloat16(o[d0][r] * rli[r]); }
    asm volatile("s_waitcnt lgkmcnt(0)" ::: "memory");
#pragma unroll
    for (int i = 0; i < 4; ++i) { const int row = i * 8 + (lane >> 3), ch = lane & 7; *(u32x4*)(Ow + (long)row * DM + ch * 8) = *(const u32x4*)(stg + row * 64 + ch * 8); }
    asm volatile("s_waitcnt lgkmcnt(0)\n\ts_barrier" ::: "memory");
#undef DMA_K
#undef DMA_V
#undef ROT
#undef EX
#undef RESC
#undef PKW
#undef PAF
#undef VFR
#undef VRD
#undef KRD
#undef ENDW
#undef GAPA
#undef GAPB
#undef STEP
#undef LDBIAS
#undef LDBIAS2
}

#undef SBAR
#undef PIN
#undef MFMA
#undef WAIT_BAR
#undef MX3
}
constexpr int NWAVES = 8;
#ifndef MK_N_LAUNCHES
#define MK_N_LAUNCHES 1
#endif
constexpr int N_PHASES = 11;
constexpr int Bn = 16, Sn = 2048, Dm = 1024, T = Bn * Sn;
constexpr int NPROJ = 6656;
constexpr float ALPHA = 1.189207115002721f;
constexpr float LN_EPS = 1e-5f;
constexpr float GLA_EPS2 = 1e-5f * 128.0f;

constexpr size_t MiB = 1u << 20;
constexpr size_t WS_CTL = 0, CTL_ZERO_BYTES = 1 * MiB;
constexpr size_t WS_WIN = 1 * MiB;
constexpr size_t WS_WOF = 14 * MiB;
constexpr size_t WS_WOG = 15 * MiB;
constexpr size_t WS_WO  = 17 * MiB;
constexpr size_t WS_WQ  = 19 * MiB;
constexpr size_t WS_SK  = 23 * MiB;
constexpr size_t WS_EU  = 24 * MiB;
constexpr size_t WS_EV  = 40 * MiB;
constexpr size_t WS_SU  = 56 * MiB;
constexpr size_t WS_SV  = 56 * MiB + 65536;
constexpr size_t WS_FF  = 88 * MiB;
constexpr size_t WS_GLR = 89 * MiB;
constexpr size_t WS_CB  = 91 * MiB;
constexpr size_t WS_XB  = 92 * MiB;
constexpr size_t WS_FQ  = 156 * MiB;
constexpr size_t WS_FK  = 188 * MiB, WS_FV = 220 * MiB, WS_GQ = 252 * MiB, WS_GK = 284 * MiB;
constexpr size_t WS_GV  = 316 * MiB;
constexpr size_t WS_GG  = 380 * MiB;
constexpr size_t WS_IDX = 444 * MiB;
constexpr size_t WS_GATE = 452 * MiB;
constexpr size_t WS_END = 468 * MiB;
constexpr size_t WS_Y = WS_FQ, WS_QP = WS_GV;
constexpr int CW_TMO = 0, CW_BAR = 4096;

constexpr int RING_BYTES = 131072;
constexpr int LDSCTL_OFF = 160 * 1024 - 512, MISC_OFF = LDSCTL_OFF + 320;
constexpr int LDS_BYTES = 160 * 1024;

typedef unsigned long long u64;
typedef unsigned v2u __attribute__((ext_vector_type(2)));
typedef float f32x16 __attribute__((ext_vector_type(16)));
typedef short s16x4v __attribute__((ext_vector_type(4)));
typedef __bf16 bf16x2_t __attribute__((ext_vector_type(2)));

__device__ __forceinline__ float bf_lo(unsigned u) { return __builtin_bit_cast(float, u << 16); }
__device__ __forceinline__ float bf_hi(unsigned u) { return __builtin_bit_cast(float, u & 0xffff0000u); }
__device__ __forceinline__ float sigmoidf_(float x) { return __builtin_amdgcn_rcpf(1.0f + __expf(-x)); }
__device__ __forceinline__ float wave_sum(float v) {
#pragma unroll
    for (int o = 1; o < 64; o <<= 1) v += __shfl_xor(v, o);
    return v;
}
__device__ __forceinline__ float dot2bf(unsigned a, unsigned b, float c) { asm("v_dot2c_f32_bf16 %0, %1, %2" : "+v"(c) : "v"(a), "v"(b)); return c; }
__device__ __forceinline__ float gelu_erf(float v) { return 0.5f * v * (1.0f + erff(v * 0.70710678118654752f)); }

namespace pg8 {
struct EpiProj {
    static constexpr bool PERM = true, AFTER_DRAIN = false;
    unsigned char* ws; unsigned char* dout;
    __device__ __forceinline__ void operator()(const f32x4 (&acc)[2][2][4][2], const Unit& u, int wr, int wc, int fr, int fq) const {
        const int pn = u.pn; bf16_t* base; int ldc, colt;
        if (pn < 10)      { base = (bf16_t*)(ws + WS_FQ + (size_t)(pn >> 1) * (32 * MiB)); ldc = 512; colt = (pn & 1) * 256; }
        else if (pn < 18) { base = (bf16_t*)(ws + WS_GV + (size_t)((pn - 10) >> 2) * (64 * MiB)); ldc = 1024; colt = ((pn - 10) & 3) * 256; }
        else              { base = (bf16_t*)(dout + (size_t)((pn - 18) >> 2) * (64 * MiB)); ldc = 1024; colt = ((pn - 18) & 3) * 256; }
        const int row0 = u.pm * BM + wr * 64 + fr, col0 = colt + wc * 32 + 8 * fq;
#pragma unroll
        for (int ai = 0; ai < 2; ++ai)
#pragma unroll
            for (int m = 0; m < 4; ++m) { bf16_t* rowp = base + (size_t)(row0 + ai * HALF + m * 16) * ldc + col0;
#pragma unroll
                for (int bj = 0; bj < 2; ++bj) { const f32x4 v0 = acc[ai][bj][m][0], v1 = acc[ai][bj][m][1];
                    u32x4 w; w.x = cvt_pk_bf16(v0[0], v0[1]); w.y = cvt_pk_bf16(v0[2], v0[3]); w.z = cvt_pk_bf16(v1[0], v1[1]); w.w = cvt_pk_bf16(v1[2], v1[3]);
                    *(u32x4*)(rowp + bj * HALF) = w; } }
    }
};
template <int MODE> struct EpiGate {
    static constexpr bool PERM = true, AFTER_DRAIN = false;
    const bf16_t* G; bf16_t* O;
    __device__ __forceinline__ void operator()(const f32x4 (&acc)[2][2][4][2], const Unit& u, int wr, int wc, int fr, int fq) const {
        const int row0 = u.pm * BM + wr * 64 + fr, col0 = u.pn * BM + wc * 32 + 8 * fq;
#pragma unroll
        for (int ai = 0; ai < 2; ++ai)
#pragma unroll
            for (int m = 0; m < 4; ++m) { const size_t off = (size_t)(row0 + ai * HALF + m * 16) * 1024 + col0;
#pragma unroll
                for (int bj = 0; bj < 2; ++bj) { const f32x4 v0 = acc[ai][bj][m][0], v1 = acc[ai][bj][m][1];
                    const u32x4 g = *(const u32x4*)(G + off + bj * HALF);
                    float r[8];
                    r[0] = v0[0] * sigmoidf_(bf_lo(g.x)); r[1] = v0[1] * sigmoidf_(bf_hi(g.x)); r[2] = v0[2] * sigmoidf_(bf_lo(g.y)); r[3] = v0[3] * sigmoidf_(bf_hi(g.y));
                    r[4] = v1[0] * sigmoidf_(bf_lo(g.z)); r[5] = v1[1] * sigmoidf_(bf_hi(g.z)); r[6] = v1[2] * sigmoidf_(bf_lo(g.w)); r[7] = v1[3] * sigmoidf_(bf_hi(g.w));
                    if (MODE == 1) { const u32x4 o = *(const u32x4*)(O + off + bj * HALF);
                        r[0] += bf_lo(o.x); r[1] += bf_hi(o.x); r[2] += bf_lo(o.y); r[3] += bf_hi(o.y); r[4] += bf_lo(o.z); r[5] += bf_hi(o.z); r[6] += bf_lo(o.w); r[7] += bf_hi(o.w); }
                    u32x4 w; w.x = cvt_pk_bf16(r[0], r[1]); w.y = cvt_pk_bf16(r[2], r[3]); w.z = cvt_pk_bf16(r[4], r[5]); w.w = cvt_pk_bf16(r[6], r[7]);
                    *(u32x4*)(O + off + bj * HALF) = w; } }
    }
};
struct EpiMix {
    static constexpr bool PERM = false, AFTER_DRAIN = false;
    const float* X; float* Y;
    __device__ __forceinline__ void operator()(const f32x4 (&acc)[2][2][4][2], const Unit& u, int wr, int wc, int fr, int fq) const {
        const int row0 = u.pm * BM + wr * 64 + fr, col0 = u.pn * BM + wc * 32 + 4 * fq;
#pragma unroll
        for (int ai = 0; ai < 2; ++ai)
#pragma unroll
            for (int m = 0; m < 4; ++m) { const size_t off = (size_t)(row0 + ai * HALF + m * 16) * 1024 + col0;
#pragma unroll
                for (int bj = 0; bj < 2; ++bj)
#pragma unroll
                    for (int n = 0; n < 2; ++n) { const f32x4 xv = *(const f32x4*)(X + off + bj * HALF + n * 16); *(f32x4*)(Y + off + bj * HALF + n * 16) = xv * ALPHA + acc[ai][bj][m][n]; } }
    }
};
}

struct Frame {
    LAS unsigned char* lds;
    volatile LAS unsigned* MISC;
    gu32* ctl;
    int tid, lane, wave, vcu, G;
};

__device__ __forceinline__ void transpose_item(const float* W, int ldw, int src_col0, bf16* WT, int K, int dst_row0, LAS float* scr, int k0, int lane) {
#pragma unroll 8
    for (int i = 0; i < 32; ++i) { const int kk = 2 * i + (lane >> 5); scr[kk * 33 + (lane & 31)] = W[(size_t)(k0 + kk) * ldw + src_col0 + (lane & 31)]; }
    LDS_WAIT(); asm volatile("" ::: "memory");
    const int c = lane & 7;
#pragma unroll
    for (int j = 0; j < 4; ++j) { const int n = (lane >> 3) + 8 * j; const LAS float* s = scr + (8 * c) * 33 + n;
        v4u o; o.x = pk2(s[0 * 33], s[1 * 33]); o.y = pk2(s[2 * 33], s[3 * 33]); o.z = pk2(s[4 * 33], s[5 * 33]); o.w = pk2(s[6 * 33], s[7 * 33]);
        *(GAS v4u*)(WT + (size_t)(dst_row0 + n) * K + k0 + 8 * c) = o; }
    LDS_WAIT(); asm volatile("" ::: "memory");
}
__device__ __forceinline__ void convert_flat(Frame& F, const float* src, bf16* dst, size_t n8) {
    const size_t gt = (size_t)F.vcu * 512 + F.tid, NT_ = (size_t)F.G * 512;
    for (size_t i = gt; i < n8; i += NT_) { const f32x4 a = *(const GAS f32x4*)(src + i * 8), b = *(const GAS f32x4*)(src + i * 8 + 4);
        v4u o; o.x = pk2(a.x, a.y); o.y = pk2(a.z, a.w); o.z = pk2(b.x, b.y); o.w = pk2(b.z, b.w); *(GAS v4u*)(dst + i * 8) = o; }
}

struct In {
    const float *x, *w_in, *fox_f_bias, *gla_gate_up, *gla_gate_bias, *gla_norm_gain, *w_out_fox, *w_out_gla, *w_out, *ln1_gain, *ln1_bias,
                *peer_w_query, *peer_sub_keys, *peer_expert_u, *peer_expert_v, *ln2_gain, *ln2_bias;
};

__device__ __forceinline__ void p0_prologue(Frame& F, const In& I, unsigned char* ws) {
    const int gw = F.vcu * NWAVES + F.wave, NGW = F.G * NWAVES;
    {
        LAS float* scr = (LAS float*)(F.lds + F.wave * 16384);
        constexpr int I_IN = 16 * 208, I_OF = 8 * 32, I_OG = 16 * 32, I_O = 16 * 32, I_Q = 16 * 64;
        constexpr int NITEMS = I_IN + I_OF + I_OG + I_O + I_Q;
        for (int it = gw; it < NITEMS; it += NGW) {
            int r = it;
            if (r < I_IN) { const int kb = r / 208, nb = r % 208; const int sc = 32 * nb + (nb >= 48 ? 8 : 0) + (nb >= 144 ? 16 : 0);
                transpose_item(I.w_in, 6680, sc, (bf16*)(ws + WS_WIN), 1024, 32 * nb, scr, 64 * kb, F.lane); continue; } r -= I_IN;
            if (r < I_OF) { const int kb = r / 32, nb = r % 32; transpose_item(I.w_out_fox, 1024, 32 * nb, (bf16*)(ws + WS_WOF), 512, 32 * nb, scr, 64 * kb, F.lane); continue; } r -= I_OF;
            if (r < I_OG) { const int kb = r / 32, nb = r % 32; transpose_item(I.w_out_gla, 1024, 32 * nb, (bf16*)(ws + WS_WOG), 1024, 32 * nb, scr, 64 * kb, F.lane); continue; } r -= I_OG;
            if (r < I_O)  { const int kb = r / 32, nb = r % 32; transpose_item(I.w_out, 1024, 32 * nb, (bf16*)(ws + WS_WO), 1024, 32 * nb, scr, 64 * kb, F.lane); continue; } r -= I_O;
            { const int kb = r / 64, nb = r % 64; transpose_item(I.peer_w_query, 2048, 32 * nb, (bf16*)(ws + WS_WQ), 1024, 32 * nb, scr, 64 * kb, F.lane); }
        }
    }
    convert_flat(F, I.peer_sub_keys, (bf16*)(ws + WS_SK), (size_t)8 * 2 * 128 * 128 / 8);
    for (int r = gw; r < 2 * 16384; r += NGW) {
        const int tab = r >> 14, row = r & 16383; const float* src = (tab ? I.peer_expert_v : I.peer_expert_u) + (size_t)row * Dm;
        const GAS f32x4* xr = (const GAS f32x4*)src + F.lane; f32x4 v[4]; float am = 0.f;
#pragma unroll
        for (int j = 0; j < 4; ++j) { v[j] = xr[64 * j]; am = fmaxf(am, fmaxf(fmaxf(fabsf(v[j].x), fabsf(v[j].y)), fmaxf(fabsf(v[j].z), fabsf(v[j].w)))); }
#pragma unroll
        for (int o = 1; o < 64; o <<= 1) am = fmaxf(am, __shfl_xor(am, o));
        const float sc = am > 0.f ? 240.0f / am : 1.0f, inv = am > 0.f ? am * (1.0f / 240.0f) : 1.0f;
        GAS unsigned* dst = (GAS unsigned*)(ws + (tab ? WS_EV : WS_EU) + (size_t)row * 1024) + F.lane;
#pragma unroll
        for (int j = 0; j < 4; ++j) { int q = __builtin_amdgcn_cvt_pk_fp8_f32(v[j].x * sc, v[j].y * sc, 0, false); q = __builtin_amdgcn_cvt_pk_fp8_f32(v[j].z * sc, v[j].w * sc, q, true); dst[64 * j] = (unsigned)q; }
        if (F.lane == 0) ((float*)(ws + (tab ? WS_SV : WS_SU)))[row] = inv;
    }
    __syncthreads();
    {
        LAS float* WSl = (LAS float*)F.lds;
        for (int idx = F.tid; idx < 24 * 1024; idx += 512) { const int k = idx / 24, j = idx % 24; const int col = j < 8 ? 1536 + j : 4616 + (j - 8);
            WSl[j * 1028 + k] = I.w_in[(size_t)k * 6680 + col]; }
        __syncthreads();
        float* FFo = (float*)(ws + WS_FF); float* GLRo = (float*)(ws + WS_GLR); bf16* XB = (bf16*)(ws + WS_XB);
        for (int m = gw; m < T; m += NGW) {
            const GAS f32x4* xr = (const GAS f32x4*)(I.x + (size_t)m * Dm) + F.lane;
            f32x4 v[4];
#pragma unroll
            for (int j = 0; j < 4; ++j) v[j] = xr[64 * j];
            GAS u64* o8 = (GAS u64*)(XB + (size_t)m * Dm) + F.lane;
#pragma unroll
            for (int j = 0; j < 4; ++j) o8[64 * j] = (u64)pk2(v[j].x, v[j].y) | ((u64)pk2(v[j].z, v[j].w) << 32);
            float mine = 0.f;
#pragma unroll 1
            for (int jo = 0; jo < 24; ++jo) { float s = 0.f;
#pragma unroll
                for (int j = 0; j < 4; ++j) { const f32x4 w = *(const LAS f32x4*)(WSl + jo * 1028 + 4 * F.lane + 256 * j); s += (v[j].x * w.x + v[j].y * w.y) + (v[j].z * w.z + v[j].w * w.w); }
                s = wave_sum(s); if (F.lane == jo) mine = s; }
            if (F.lane < 8) FFo[(size_t)m * 8 + F.lane] = mine; else if (F.lane < 24) GLRo[(size_t)m * 16 + (F.lane - 8)] = mine;
        }
    }
}

__device__ __forceinline__ void p1_forget_cumsum(Frame& F, const In& I, unsigned char* ws) {
    if (F.vcu >= 128) return;
    const int b = F.vcu >> 3, h = F.vcu & 7; const float fb = I.fox_f_bias[h];
    const float* FFi = (const float*)(ws + WS_FF); float* CB = (float*)(ws + WS_CB) + (size_t)F.vcu * Sn;
    LAS float* wt = (LAS float*)F.lds;
    float ls[4]; float run = 0.f;
#pragma unroll
    for (int j = 0; j < 4; ++j) { const float f = FFi[((size_t)b * Sn + 4 * F.tid + j) * 8 + h] + fb; const float l = fminf(f, 0.f) - __logf(1.0f + __expf(-fabsf(f))); run += l; ls[j] = run; }
    float inc = run;
#pragma unroll
    for (int o = 1; o < 64; o <<= 1) { const float t = __shfl_up(inc, o); if (F.lane >= o) inc += t; }
    if (F.lane == 63) wt[F.wave] = inc;
    __syncthreads();
    float woff = 0.f;
#pragma unroll
    for (int w = 0; w < 8; ++w) if (w < F.wave) woff += wt[w];
    const float off = woff + inc - run;
    f32x4 o; o.x = -8.f * (off + ls[0]); o.y = -8.f * (off + ls[1]); o.z = -8.f * (off + ls[2]); o.w = -8.f * (off + ls[3]);
    *(GAS f32x4*)(CB + 4 * F.tid) = o;
    __syncthreads();
}

namespace gla {
typedef __attribute__((address_space(3))) unsigned char* lptr;
typedef __attribute__((address_space(3))) const unsigned char* lcptr;
typedef short v4i16_t __attribute__((ext_vector_type(4)));
constexpr int KD_STRIDE = 320, V_STRIDE = 576, Q_STRIDE = 264, G_STRIDE = 520;
constexpr int L_KD = 0, L_V = 20480, L_Q = 57344, L_G = 74240, L_GLR = 107520, L_CT = 111616, L_DT = 113664, L_RS = 114176, GLA_LDS = 116224;
__device__ __forceinline__ s16x4v tr4(lcptr p) { return __builtin_bit_cast(s16x4v, __builtin_amdgcn_ds_read_tr16_b64_v4i16((__attribute__((address_space(3))) v4i16_t*)p)); }
__device__ __forceinline__ int crow(int r, int hi) { return (r & 3) + 8 * (r >> 2) + 4 * hi; }
typedef float f32x2_t __attribute__((ext_vector_type(2)));
__device__ __forceinline__ unsigned cvtpk(float lo, float hi) { const f32x2_t v = {lo, hi}; const bf16x2_t bb = __builtin_convertvector(v, bf16x2_t); return __builtin_bit_cast(unsigned, bb); }

struct Pre { v4u k[2], q[2], v[4], g[4], glr; };

__device__ __forceinline__ void load_chunk(Pre& P, int tid, size_t row0, int h, const bf16* GQ, const bf16* GK, const bf16* GV, const bf16* GG, const float* GLRi) {
#pragma unroll
    for (int j = 0; j < 2; ++j) { const int p = tid + 512 * j, row = p >> 4, c = p & 15;
        P.k[j] = *(const GAS v4u*)(GK + (row0 + row) * 512 + h * 128 + c * 8); P.q[j] = *(const GAS v4u*)(GQ + (row0 + row) * 512 + h * 128 + c * 8); }
#pragma unroll
    for (int j = 0; j < 4; ++j) { const int p = tid + 512 * j, row = p >> 5, c = p & 31;
        P.v[j] = *(const GAS v4u*)(GV + (row0 + row) * 1024 + h * 256 + c * 8); P.g[j] = *(const GAS v4u*)(GG + (row0 + row) * 1024 + h * 256 + c * 8); }
    if (tid < 256) P.glr = *(const GAS v4u*)(GLRi + row0 * 16 + tid * 4);
}
__device__ __forceinline__ void store_chunk(const Pre& P, int tid, lptr lds) {
#pragma unroll
    for (int j = 0; j < 2; ++j) { const int p = tid + 512 * j, row = p >> 4, c = p & 15;
        *(__attribute__((address_space(3))) v4u*)(lds + L_KD + row * KD_STRIDE + c * 16) = P.k[j];
        __attribute__((address_space(3))) v2u* qd = (__attribute__((address_space(3))) v2u*)(lds + L_Q + row * Q_STRIDE + c * 16);
        qd[0] = (v2u){P.q[j].x, P.q[j].y}; qd[1] = (v2u){P.q[j].z, P.q[j].w}; }
#pragma unroll
    for (int j = 0; j < 4; ++j) { const int p = tid + 512 * j, row = p >> 5, c = p & 31;
        *(__attribute__((address_space(3))) v4u*)(lds + L_V + row * V_STRIDE + c * 16) = P.v[j];
        __attribute__((address_space(3))) v2u* gd = (__attribute__((address_space(3))) v2u*)(lds + L_G + row * G_STRIDE + c * 16);
        gd[0] = (v2u){P.g[j].x, P.g[j].y}; gd[1] = (v2u){P.g[j].z, P.g[j].w}; }
    if (tid < 256) *(__attribute__((address_space(3))) v4u*)(lds + L_GLR + tid * 16) = P.glr;
}

__device__ __forceinline__ void gla_unit(int b, int h, const bf16* GQ, const bf16* GK, const bf16* GV, const bf16* GG, const float* GLRi,
                                         const float* up, const float* gbias, const float* gain, bf16* OG, lptr lds) {
    const int tid = threadIdx.x, lane = tid & 63, r32 = lane & 31, hi = lane >> 5; const int wid = __builtin_amdgcn_readfirstlane(tid >> 6);
    const int d = tid & 127, qt = tid >> 7;
    float upr[16];
#pragma unroll
    for (int r = 0; r < 16; ++r) upr[r] = up[r * 512 + h * 128 + d];
    const float bz = gbias[h * 128 + d];
    f32x16 S[4];
#pragma unroll
    for (int rb = 0; rb < 4; ++rb) S[rb] = f32x16{};
    const size_t rowb = (size_t)b * Sn;
    Pre P;
    load_chunk(P, tid, rowb, h, GQ, GK, GV, GG, GLRi);
    store_chunk(P, tid, lds);
    __syncthreads();
    const int G4 = lane >> 4, q4 = (lane & 15) >> 2, p4 = lane & 3, cb16 = G4 & 1;
    const lcptr a_base = (lcptr)lds + L_KD + (8 * hi + q4) * KD_STRIDE + (16 * cb16 + 4 * p4) * 2;
    const lcptr b_base = (lcptr)lds + L_V + (8 * hi + q4) * V_STRIDE + (32 * wid + 16 * cb16 + 4 * p4) * 2;
    for (int c = 0; c < 32; ++c) {
        if (c + 1 < 32) load_chunk(P, tid, rowb + (size_t)(c + 1) * 64, h, GQ, GK, GV, GG, GLRi);
        {
            float cumv[16]; float run = 0.f;
#pragma unroll
            for (int ii = 0; ii < 16; ++ii) { const __attribute__((address_space(3))) f32x4* gp = (const __attribute__((address_space(3))) f32x4*)(lds + L_GLR + (16 * qt + ii) * 64);
                const f32x4 g0 = gp[0], g1 = gp[1], g2 = gp[2], g3 = gp[3];
                float z = bz;
                z += g0.x * upr[0] + g0.y * upr[1] + g0.z * upr[2] + g0.w * upr[3];
                z += g1.x * upr[4] + g1.y * upr[5] + g1.z * upr[6] + g1.w * upr[7];
                z += g2.x * upr[8] + g2.y * upr[9] + g2.z * upr[10] + g2.w * upr[11];
                z += g3.x * upr[12] + g3.y * upr[13] + g3.z * upr[14] + g3.w * upr[15];
                const float la = (fminf(z, 0.f) - __logf(1.0f + __expf(-fabsf(z)))) * (1.0f / 16.0f);
                run += la; cumv[ii] = run; }
            __attribute__((address_space(3))) float* CT = (__attribute__((address_space(3))) float*)(lds + L_CT);
            CT[qt * 128 + d] = run;
            __syncthreads();
            const float t0 = CT[d], t1 = CT[128 + d], t2 = CT[256 + d], t3 = CT[384 + d];
            const float total = (t0 + t1) + (t2 + t3);
            const float off = (qt > 0 ? t0 : 0.f) + (qt > 1 ? t1 : 0.f) + (qt > 2 ? t2 : 0.f);
#pragma unroll
            for (int ii = 0; ii < 16; ++ii) { __attribute__((address_space(3))) unsigned short* kp = (__attribute__((address_space(3))) unsigned short*)(lds + L_KD + (16 * qt + ii) * KD_STRIDE + d * 2);
                const float kf = __builtin_bit_cast(float, (unsigned)(*kp) << 16) * __expf(total - (off + cumv[ii]));
                *kp = (unsigned short)f2bf(kf); }
            if (qt == 0) ((__attribute__((address_space(3))) float*)(lds + L_DT))[d] = __expf(total);
            __syncthreads();
        }
        {
#pragma unroll
            for (int rb = 0; rb < 4; ++rb)
#pragma unroll
                for (int g = 0; g < 4; ++g) { const f32x4 dt = *(const __attribute__((address_space(3))) f32x4*)(lds + L_DT + (32 * rb + 8 * g + 4 * hi) * 4);
                    S[rb][4 * g] *= dt.x; S[rb][4 * g + 1] *= dt.y; S[rb][4 * g + 2] *= dt.z; S[rb][4 * g + 3] *= dt.w; }
#pragma unroll
            for (int s = 0; s < 4; ++s) {
                const s16x4v b0 = tr4(b_base + s * 16 * V_STRIDE), b1 = tr4(b_base + s * 16 * V_STRIDE + 4 * V_STRIDE);
                const bf16x8 bf = (bf16x8){b0[0], b0[1], b0[2], b0[3], b1[0], b1[1], b1[2], b1[3]};
#pragma unroll
                for (int rb = 0; rb < 4; ++rb) {
                    const s16x4v a0 = tr4(a_base + s * 16 * KD_STRIDE + rb * 64), a1 = tr4(a_base + s * 16 * KD_STRIDE + 4 * KD_STRIDE + rb * 64);
                    const bf16x8 af = (bf16x8){a0[0], a0[1], a0[2], a0[3], a1[0], a1[1], a1[2], a1[3]};
                    S[rb] = __builtin_amdgcn_mfma_f32_32x32x16_bf16(af, bf, S[rb], 0, 0, 0);
                }
            }
        }
        f32x16 ob[2]; ob[0] = f32x16{}; ob[1] = f32x16{};
        {
#pragma unroll
            for (int rb = 0; rb < 4; ++rb)
#pragma unroll
                for (int s2 = 0; s2 < 2; ++s2) {
                    v4u sp; sp.x = cvtpk(S[rb][8 * s2 + 0], S[rb][8 * s2 + 1]); sp.y = cvtpk(S[rb][8 * s2 + 2], S[rb][8 * s2 + 3]);
                    sp.z = cvtpk(S[rb][8 * s2 + 4], S[rb][8 * s2 + 5]); sp.w = cvtpk(S[rb][8 * s2 + 6], S[rb][8 * s2 + 7]);
                    const bf16x8 sf = __builtin_bit_cast(bf16x8, sp);
#pragma unroll
                    for (int ib = 0; ib < 2; ++ib) {
                        const lcptr qrow = (lcptr)lds + L_Q + (32 * ib + r32) * Q_STRIDE + (32 * rb + 16 * s2 + 4 * hi) * 2;
                        const v2u lo = *(const __attribute__((address_space(3))) v2u*)(qrow), hi2 = *(const __attribute__((address_space(3))) v2u*)(qrow + 16);
                        const bf16x8 qf = __builtin_bit_cast(bf16x8, (v4u){lo.x, lo.y, hi2.x, hi2.y});
                        ob[ib] = __builtin_amdgcn_mfma_f32_32x32x16_bf16(sf, qf, ob[ib], 0, 0, 0);
                    }
                }
        }
        {
            __attribute__((address_space(3))) float* RS = (__attribute__((address_space(3))) float*)(lds + L_RS);
#pragma unroll
            for (int ib = 0; ib < 2; ++ib) { float ss = 0.f;
#pragma unroll
                for (int r = 0; r < 16; ++r) ss += ob[ib][r] * ob[ib][r];
                auto rr = __builtin_amdgcn_permlane32_swap(__float_as_uint(ss), __float_as_uint(ss), false, false); ss = __uint_as_float(rr[0]) + __uint_as_float(rr[1]);
                if (hi == 0) RS[wid * 64 + 32 * ib + r32] = ss; }
            __syncthreads();
#pragma unroll
            for (int ib = 0; ib < 2; ++ib) { const int i = 32 * ib + r32; float tot = 0.f;
#pragma unroll
                for (int w = 0; w < 8; ++w) tot += RS[w * 64 + i];
                const float rstd = __builtin_amdgcn_rsqf(tot * (1.0f / 256.0f) + GLA_EPS2);
#pragma unroll
                for (int g = 0; g < 4; ++g) { __attribute__((address_space(3))) v2u* gp = (__attribute__((address_space(3))) v2u*)(lds + L_G + i * G_STRIDE + (32 * wid + 8 * g + 4 * hi) * 2);
                    const v2u gg = *gp; const f32x4 gn = *(const GAS f32x4*)(gain + h * 256 + 32 * wid + 8 * g + 4 * hi);
                    const float x0 = bf_lo(gg.x), x1 = bf_hi(gg.x), x2 = bf_lo(gg.y), x3 = bf_hi(gg.y);
                    const float o0 = ob[ib][4 * g] * rstd * gn.x * (x0 * sigmoidf_(x0)), o1 = ob[ib][4 * g + 1] * rstd * gn.y * (x1 * sigmoidf_(x1));
                    const float o2 = ob[ib][4 * g + 2] * rstd * gn.z * (x2 * sigmoidf_(x2)), o3 = ob[ib][4 * g + 3] * rstd * gn.w * (x3 * sigmoidf_(x3));
                    *gp = (v2u){cvtpk(o0, o1), cvtpk(o2, o3)}; } }
            __syncthreads();
        }
        {
#pragma unroll
            for (int j = 0; j < 4; ++j) { const int p = tid + 512 * j, row = p >> 5, cc = p & 31;
                const __attribute__((address_space(3))) v2u* gs = (const __attribute__((address_space(3))) v2u*)(lds + L_G + row * G_STRIDE + cc * 16);
                const v2u a = gs[0], bb = gs[1];
                *(GAS v4u*)(OG + (rowb + (size_t)c * 64 + row) * 1024 + h * 256 + cc * 8) = (v4u){a.x, a.y, bb.x, bb.y}; }
            __syncthreads();
        }
        if (c + 1 < 32) { store_chunk(P, tid, lds); }
        __syncthreads();
    }
}
}

__device__ __forceinline__ void p7_ln1(Frame& F, const In& I, unsigned char* ws) {
    const int gw = F.vcu * NWAVES + F.wave, NGW = F.G * NWAVES;
    const float* Y = (const float*)(ws + WS_Y); bf16* X1 = (bf16*)(ws + WS_XB);
    f32x4 gv[4], bv[4];
#pragma unroll
    for (int j = 0; j < 4; ++j) { gv[j] = *((const GAS f32x4*)I.ln1_gain + F.lane + 64 * j); bv[j] = *((const GAS f32x4*)I.ln1_bias + F.lane + 64 * j); }
    for (int m = gw; m < T; m += NGW) {
        const GAS f32x4* yr = (const GAS f32x4*)(Y + (size_t)m * Dm) + F.lane;
        f32x4 v[4]; float s = 0.f;
#pragma unroll
        for (int j = 0; j < 4; ++j) { v[j] = yr[64 * j]; s += (v[j].x + v[j].y) + (v[j].z + v[j].w); }
        const float mean = wave_sum(s) * (1.f / Dm); float s2 = 0.f;
#pragma unroll
        for (int j = 0; j < 4; ++j) { v[j] = v[j] - mean; s2 += (v[j].x * v[j].x + v[j].y * v[j].y) + (v[j].z * v[j].z + v[j].w * v[j].w); }
        const float rstd = 1.f / sqrtf(wave_sum(s2) * (1.f / Dm) + LN_EPS);
        GAS u64* o8 = (GAS u64*)(X1 + (size_t)m * Dm) + F.lane;
#pragma unroll
        for (int j = 0; j < 4; ++j) { const f32x4 o = v[j] * rstd * gv[j] + bv[j]; o8[64 * j] = (u64)pk2(o.x, o.y) | ((u64)pk2(o.z, o.w) << 32); }
    }
}

namespace topk {
template <int LO, int CNT, bool DESC> __device__ __forceinline__ void bmerge(unsigned* k) {
    if constexpr (CNT > 1) { constexpr int H = CNT / 2;
#pragma unroll
        for (int i = 0; i < H; ++i) { const unsigned a = k[LO + i], b = k[LO + i + H]; const unsigned mx = a > b ? a : b, mn = a > b ? b : a; k[LO + i] = DESC ? mx : mn; k[LO + i + H] = DESC ? mn : mx; }
        bmerge<LO, H, DESC>(k); bmerge<LO + H, H, DESC>(k); }
}
template <int LO, int CNT, bool DESC> __device__ __forceinline__ void bsort(unsigned* k) {
    if constexpr (CNT > 1) { bsort<LO, CNT / 2, true>(k); bsort<LO + CNT / 2, CNT / 2, false>(k); bmerge<LO, CNT, DESC>(k); }
}
__device__ __forceinline__ void top16_of_64(unsigned* k) {
    bsort<0, 16, true>(k); bsort<16, 16, false>(k);
#pragma unroll
    for (int i = 0; i < 16; ++i) k[i] = k[i] > k[16 + i] ? k[i] : k[16 + i];
    bmerge<0, 16, true>(k);
    bsort<32, 16, true>(k); bsort<48, 16, false>(k);
#pragma unroll
    for (int i = 0; i < 16; ++i) k[32 + i] = k[32 + i] > k[48 + i] ? k[32 + i] : k[48 + i];
    bmerge<32, 16, false>(k);
#pragma unroll
    for (int i = 0; i < 16; ++i) k[i] = k[i] > k[32 + i] ? k[i] : k[32 + i];
    bmerge<0, 16, true>(k);
}
__device__ __forceinline__ void merge_halves(unsigned* k, int hi) {
    unsigned p[16];
#pragma unroll
    for (int i = 0; i < 16; ++i) { auto rr = __builtin_amdgcn_permlane32_swap(k[i], k[i], false, false); p[i] = hi ? rr[0] : rr[1]; }
#pragma unroll
    for (int i = 0; i < 16; ++i) k[i] = k[i] > p[15 - i] ? k[i] : p[15 - i];
    bmerge<0, 16, true>(k);
}
__device__ __forceinline__ unsigned fmap(float f) { const unsigned u = __float_as_uint(f); const unsigned m = (unsigned)((int)u >> 31); return u ^ (m | 0x80000000u); }
__device__ __forceinline__ float funmap(unsigned k) { const unsigned m = (unsigned)((int)k >> 31); return __uint_as_float(k ^ (~m | 0x80000000u)); }
struct CandTab { unsigned char i[50], j[50]; };
__host__ __device__ constexpr CandTab make_cands() { CandTab t{}; int n = 0; for (int i = 0; i < 16; ++i) for (int j = 0; j < 16; ++j) if ((i + 1) * (j + 1) <= 16) { t.i[n] = (unsigned char)i; t.j[n] = (unsigned char)j; ++n; } return t; }
constexpr CandTab CT_ = make_cands();
constexpr int SK_LDS = 65536, NL_OFF = 65536;

__device__ __forceinline__ void task(int t0, int h, const bf16* QP, unsigned short* IDX, float* GATE, __attribute__((address_space(3))) const unsigned char* SKl,
                                     __attribute__((address_space(3))) unsigned char* NL, int lane) {
    const int r32 = lane & 31, hi = lane >> 5;
    unsigned K0[16], K1[16];
#pragma unroll
    for (int p = 0; p < 2; ++p) {
        bf16x8 qf[8];
#pragma unroll
        for (int ks = 0; ks < 8; ++ks) qf[ks] = *(const GAS bf16x8*)(QP + (size_t)(t0 + r32) * 2048 + h * 256 + p * 128 + 16 * ks + 8 * hi);
        f32x16 acc[4];
#pragma unroll
        for (int nb = 0; nb < 4; ++nb) { acc[nb] = f32x16{};
#pragma unroll
            for (int ks = 0; ks < 8; ++ks) { const int n = 32 * nb + r32;
                const bf16x8 af = *(const __attribute__((address_space(3))) bf16x8*)(SKl + p * 32768 + n * 256 + (((2 * ks + hi) ^ (n & 15)) << 4));
                acc[nb] = __builtin_amdgcn_mfma_f32_32x32x16_bf16(af, qf[ks], acc[nb], 0, 0, 0); } }
        unsigned k[64];
#pragma unroll
        for (int nb = 0; nb < 4; ++nb)
#pragma unroll
            for (int r = 0; r < 16; ++r) k[16 * nb + r] = (fmap(acc[nb][r]) & ~127u) | (unsigned)(32 * nb + (r & 3) + 8 * (r >> 2)) | (unsigned)(4 * hi);
        top16_of_64(k);
        merge_halves(k, hi);
#pragma unroll
        for (int i = 0; i < 16; ++i) { if (p == 0) K0[i] = k[i]; else K1[i] = k[i]; }
    }
    { unsigned w0 = 0, w1 = 0, w2 = 0, w3 = 0;
#pragma unroll
      for (int i = 0; i < 4; ++i) { const unsigned a = hi ? K1[i] : K0[i], b = hi ? K1[4 + i] : K0[4 + i], c = hi ? K1[8 + i] : K0[8 + i], d = hi ? K1[12 + i] : K0[12 + i];
          w0 |= (a & 127u) << (8 * i); w1 |= (b & 127u) << (8 * i); w2 |= (c & 127u) << (8 * i); w3 |= (d & 127u) << (8 * i); }
      *(__attribute__((address_space(3))) v4u*)(NL + r32 * 32 + hi * 16) = (v4u){w0, w1, w2, w3}; }
    float v0[16], v1[16];
#pragma unroll
    for (int i = 0; i < 16; ++i) { v0[i] = funmap(K0[i] & ~127u); v1[i] = funmap(K1[i] & ~127u); }
    unsigned k[64];
#pragma unroll
    for (int c = 0; c < 64; ++c) { if (c < 50) { const float s = v0[CT_.i[c]] + v1[CT_.j[c]]; k[c] = (fmap(s) & ~255u) | (unsigned)(CT_.i[c] * 16 + CT_.j[c]); } else k[c] = 0u; }
    top16_of_64(k);
    float best[16]; float sum = 0.f; const float mx = funmap(k[0] & ~255u);
#pragma unroll
    for (int r = 0; r < 16; ++r) { best[r] = __expf(funmap(k[r] & ~255u) - mx); sum += best[r]; }
    const float rs = 1.0f / sum;
    asm volatile("s_waitcnt lgkmcnt(0)" ::: "memory");
    unsigned short idx[8]; float gt[8];
#pragma unroll
    for (int r = 0; r < 8; ++r) { const unsigned kk = hi ? k[8 + r] : k[r]; const float g = (hi ? best[8 + r] : best[r]) * rs;
        const unsigned n0 = NL[r32 * 32 + ((kk >> 4) & 15u)], n1 = NL[r32 * 32 + 16 + (kk & 15u)];
        idx[r] = (unsigned short)(n0 * 128u + n1); gt[r] = g; }
    v4u iw; iw.x = idx[0] | ((unsigned)idx[1] << 16); iw.y = idx[2] | ((unsigned)idx[3] << 16); iw.z = idx[4] | ((unsigned)idx[5] << 16); iw.w = idx[6] | ((unsigned)idx[7] << 16);
    const size_t t = (size_t)(t0 + r32);
    *(GAS v4u*)(IDX + t * 128 + h * 16 + 8 * hi) = iw;
    *(GAS f32x4*)(GATE + t * 128 + h * 16 + 8 * hi) = (f32x4){gt[0], gt[1], gt[2], gt[3]};
    *(GAS f32x4*)(GATE + t * 128 + h * 16 + 8 * hi + 4) = (f32x4){gt[4], gt[5], gt[6], gt[7]};
    asm volatile("s_waitcnt lgkmcnt(0)" ::: "memory");
}
}

__device__ __forceinline__ void p9_topk(Frame& F, unsigned char* ws) {
    const int h = F.vcu & 7, cg = F.vcu >> 3;
    const bf16* SK = (const bf16*)(ws + WS_SK) + (size_t)h * 32768;
    for (int g = F.tid; g < 4096; g += 512) { const int p = g >> 11, n = (g >> 4) & 127, ch = g & 15;
        *(LAS v4u*)(F.lds + p * 32768 + n * 256 + ((ch ^ (n & 15)) << 4)) = *(const GAS v4u*)(SK + (size_t)g * 8); }
    __syncthreads();
    for (int j = 0; j < 4; ++j) { const int tg = cg * 32 + F.wave * 4 + j;
        topk::task(tg * 32, h, (const bf16*)(ws + WS_QP), (unsigned short*)(ws + WS_IDX), (float*)(ws + WS_GATE), F.lds, F.lds + topk::NL_OFF + F.wave * 1024, F.lane); }
    __syncthreads();
}

typedef float f32x2v __attribute__((ext_vector_type(2)));
__device__ __forceinline__ void p10_experts(Frame& F, const In& I, unsigned char* ws, float* out) {
    const int gw = F.vcu * NWAVES + F.wave, NGW = F.G * NWAVES; const int lane = F.lane;
    const bf16* X1 = (const bf16*)(ws + WS_XB); const unsigned char* EU = ws + WS_EU; const unsigned char* EV = ws + WS_EV;
    const float* SU = (const float*)(ws + WS_SU); const float* SV = (const float*)(ws + WS_SV);
    const unsigned short* IDX = (const unsigned short*)(ws + WS_IDX); const float* GATE = (const float*)(ws + WS_GATE);
    const int sel = ((lane >> 5) & 1) * 4 + ((lane >> 4) & 1) * 2 + ((lane >> 3) & 1);
    for (int t = gw; t < T; t += NGW) {
        const v4u hb0 = *(const GAS v4u*)(X1 + (size_t)t * Dm + 16 * lane), hb1 = *(const GAS v4u*)(X1 + (size_t)t * Dm + 16 * lane + 8);
        f32x2v h[8];
        h[0] = (f32x2v){bf_lo(hb0.x), bf_hi(hb0.x)}; h[1] = (f32x2v){bf_lo(hb0.y), bf_hi(hb0.y)}; h[2] = (f32x2v){bf_lo(hb0.z), bf_hi(hb0.z)}; h[3] = (f32x2v){bf_lo(hb0.w), bf_hi(hb0.w)};
        h[4] = (f32x2v){bf_lo(hb1.x), bf_hi(hb1.x)}; h[5] = (f32x2v){bf_lo(hb1.y), bf_hi(hb1.y)}; h[6] = (f32x2v){bf_lo(hb1.z), bf_hi(hb1.z)}; h[7] = (f32x2v){bf_lo(hb1.w), bf_hi(hb1.w)};
        const unsigned ia = IDX[(size_t)t * 128 + lane], ib = IDX[(size_t)t * 128 + 64 + lane];
        const float sua = SU[ia], sub = SU[ib];
        const float gva = GATE[(size_t)t * 128 + lane] * SV[ia], gvb = GATE[(size_t)t * 128 + 64 + lane] * SV[ib];
        f32x2v acc[8];
#pragma unroll
        for (int i = 0; i < 8; ++i) acc[i] = (f32x2v){0.f, 0.f};
        int e[8]; v4u u[8];
#pragma unroll
        for (int j = 0; j < 8; ++j) { e[j] = __builtin_amdgcn_readlane(ia, j); u[j] = *(const GAS v4u*)(EU + (size_t)e[j] * 1024 + 16 * lane); }
        for (int bt = 0; bt < 16; ++bt) {
            float p[8];
#pragma unroll
            for (int j = 0; j < 8; ++j) { f32x2v s2 = (f32x2v){0.f, 0.f};
                s2 = __builtin_elementwise_fma(__builtin_amdgcn_cvt_pk_f32_fp8((int)u[j].x, false), h[0], s2); s2 = __builtin_elementwise_fma(__builtin_amdgcn_cvt_pk_f32_fp8((int)u[j].x, true), h[1], s2);
                s2 = __builtin_elementwise_fma(__builtin_amdgcn_cvt_pk_f32_fp8((int)u[j].y, false), h[2], s2); s2 = __builtin_elementwise_fma(__builtin_amdgcn_cvt_pk_f32_fp8((int)u[j].y, true), h[3], s2);
                s2 = __builtin_elementwise_fma(__builtin_amdgcn_cvt_pk_f32_fp8((int)u[j].z, false), h[4], s2); s2 = __builtin_elementwise_fma(__builtin_amdgcn_cvt_pk_f32_fp8((int)u[j].z, true), h[5], s2);
                s2 = __builtin_elementwise_fma(__builtin_amdgcn_cvt_pk_f32_fp8((int)u[j].w, false), h[6], s2); s2 = __builtin_elementwise_fma(__builtin_amdgcn_cvt_pk_f32_fp8((int)u[j].w, true), h[7], s2);
                p[j] = s2.x + s2.y; }
            v4u x[8];
#pragma unroll
            for (int j = 0; j < 8; ++j) x[j] = *(const GAS v4u*)(EV + (size_t)e[j] * 1024 + 16 * lane);
            if (bt + 1 < 16) {
#pragma unroll
                for (int j = 0; j < 8; ++j) { const int kx = 8 * (bt + 1) + j; e[j] = __builtin_amdgcn_readlane(kx < 64 ? ia : ib, kx & 63); u[j] = *(const GAS v4u*)(EU + (size_t)e[j] * 1024 + 16 * lane); }
            }
            float q4[4], q2[2], q1;
            { const bool up_ = (lane & 32) != 0;
#pragma unroll
              for (int j = 0; j < 4; ++j) { const float send = up_ ? p[j] : p[4 + j], keep = up_ ? p[4 + j] : p[j]; q4[j] = keep + __shfl_xor(send, 32); } }
            { const bool up_ = (lane & 16) != 0;
#pragma unroll
              for (int j = 0; j < 2; ++j) { const float send = up_ ? q4[j] : q4[2 + j], keep = up_ ? q4[2 + j] : q4[j]; q2[j] = keep + __shfl_xor(send, 16); } }
            { const bool up_ = (lane & 8) != 0; const float send = up_ ? q2[0] : q2[1], keep = up_ ? q2[1] : q2[0]; q1 = keep + __shfl_xor(send, 8); }
            q1 += __shfl_xor(q1, 4); q1 += __shfl_xor(q1, 2); q1 += __shfl_xor(q1, 1);
            const int kx = 8 * bt + sel;
            const float susel = __shfl(kx < 64 ? sua : sub, kx & 63), gvsel = __shfl(kx < 64 ? gva : gvb, kx & 63);
            const float wv = gelu_erf(q1 * susel) * gvsel;
#pragma unroll
            for (int j = 0; j < 8; ++j) { const float w = __builtin_bit_cast(float, __builtin_amdgcn_readlane(__builtin_bit_cast(int, wv), ((j >> 2) & 1) * 32 + ((j >> 1) & 1) * 16 + (j & 1) * 8));
                const f32x2v w2 = (f32x2v){w, w};
                acc[0] = __builtin_elementwise_fma(__builtin_amdgcn_cvt_pk_f32_fp8((int)x[j].x, false), w2, acc[0]); acc[1] = __builtin_elementwise_fma(__builtin_amdgcn_cvt_pk_f32_fp8((int)x[j].x, true), w2, acc[1]);
                acc[2] = __builtin_elementwise_fma(__builtin_amdgcn_cvt_pk_f32_fp8((int)x[j].y, false), w2, acc[2]); acc[3] = __builtin_elementwise_fma(__builtin_amdgcn_cvt_pk_f32_fp8((int)x[j].y, true), w2, acc[3]);
                acc[4] = __builtin_elementwise_fma(__builtin_amdgcn_cvt_pk_f32_fp8((int)x[j].z, false), w2, acc[4]); acc[5] = __builtin_elementwise_fma(__builtin_amdgcn_cvt_pk_f32_fp8((int)x[j].z, true), w2, acc[5]);
                acc[6] = __builtin_elementwise_fma(__builtin_amdgcn_cvt_pk_f32_fp8((int)x[j].w, false), w2, acc[6]); acc[7] = __builtin_elementwise_fma(__builtin_amdgcn_cvt_pk_f32_fp8((int)x[j].w, true), w2, acc[7]); }
        }
        float y[16];
#pragma unroll
        for (int i = 0; i < 8; ++i) { y[2 * i] = ALPHA * h[i].x + acc[i].x; y[2 * i + 1] = ALPHA * h[i].y + acc[i].y; }
        float s = 0.f;
#pragma unroll
        for (int i = 0; i < 16; ++i) s += y[i];
        const float mean = wave_sum(s) * (1.f / Dm); float s2 = 0.f;
#pragma unroll
        for (int i = 0; i < 16; ++i) { y[i] -= mean; s2 += y[i] * y[i]; }
        const float rstd = 1.f / sqrtf(wave_sum(s2) * (1.f / Dm) + LN_EPS);
#pragma unroll
        for (int c = 0; c < 4; ++c) { const int col = 16 * lane + 4 * c;
            const f32x4 g0 = *(const GAS f32x4*)(I.ln2_gain + col), b0 = *(const GAS f32x4*)(I.ln2_bias + col);
            f32x4 o0; o0.x = y[4 * c + 0] * rstd * g0.x + b0.x; o0.y = y[4 * c + 1] * rstd * g0.y + b0.y; o0.z = y[4 * c + 2] * rstd * g0.z + b0.z; o0.w = y[4 * c + 3] * rstd * g0.w + b0.w;
            *(GAS f32x4*)(out + (size_t)t * Dm + col) = o0; }
    }
}

struct Args { const float* in[17]; float* out; unsigned char* ws; int ph_lo, ph_hi, li, pad; };
__global__ void __launch_bounds__(NWAVES * 64, 2) mk_fwd(Args args) {
    extern __shared__ __attribute__((aligned(16))) unsigned char lds[];
    Frame F;
    F.lds = (LAS unsigned char*)lds;
    F.MISC = (volatile LAS unsigned*)(F.lds + MISC_OFF);
    F.tid = threadIdx.x; F.lane = F.tid & 63; F.wave = __builtin_amdgcn_readfirstlane(F.tid >> 6);
    F.G = gridDim.x; { const int bx = blockIdx.x; F.vcu = (F.G % 8 == 0) ? (bx % 8) * (F.G / 8) + bx / 8 : bx; }
    unsigned char* ws = args.ws;
    F.ctl = (gu32*)(ws + WS_CTL);
    In I; I.x = args.in[0]; I.w_in = args.in[1]; I.fox_f_bias = args.in[2]; I.gla_gate_up = args.in[3]; I.gla_gate_bias = args.in[4]; I.gla_norm_gain = args.in[5];
    I.w_out_fox = args.in[6]; I.w_out_gla = args.in[7]; I.w_out = args.in[8]; I.ln1_gain = args.in[9]; I.ln1_bias = args.in[10]; I.peer_w_query = args.in[11];
    I.peer_sub_keys = args.in[12]; I.peer_expert_u = args.in[13]; I.peer_expert_v = args.in[14]; I.ln2_gain = args.in[15]; I.ln2_bias = args.in[16];
    for (int u = F.tid; u < (LDS_BYTES - LDSCTL_OFF) / 4; u += NWAVES * 64) ((LAS unsigned*)(F.lds + LDSCTL_OFF))[u] = 0u;
    __syncthreads();
    XcdBarrier bar = xcd_barrier_post((unsigned*)(F.ctl + CW_BAR) + args.li * XCD_BAR_WORDS, F.MISC + 8);
    const int lo = args.ph_lo, hi = args.ph_hi;
#ifndef MK_ONLY
#define MK_ONLY -1
#endif
#define IN(k) ((MK_ONLY < 0 || MK_ONLY == (k)) && lo <= (k) && (k) < hi)
#if defined(MK_TIME_A)
    unsigned long long stamps_[N_PHASES + 1]; const bool stamper_ = (blockIdx.x == 0 && F.tid == 0);
#define STAMP(k) do { __builtin_amdgcn_sched_barrier(0); { unsigned long long t_; asm volatile("s_memrealtime %0\n\ts_waitcnt lgkmcnt(0)" : "=s"(t_) :: "memory"); if (stamper_) stamps_[k] = t_; } __builtin_amdgcn_sched_barrier(0); } while (0)
#else
#define STAMP(k) do { } while (0)
#endif
#define SEAM(k) do { if (IN(k) && IN((k) + 1)) xcd_barrier(bar); STAMP((k) + 1); } while (0)
    STAMP(0);

    if (IN(0)) { p0_prologue(F, I, ws); } SEAM(0);

    if (IN(1)) {
        p1_forget_cumsum(F, I, ws);
        pg8::Gemm g{(const pg8::bf16_t*)(ws + WS_XB), (const pg8::bf16_t*)(ws + WS_WIN), T, NPROJ, Dm}; pg8::StaticOrder S; S.init(T, NPROJ, F.G, (int)blockIdx.x);
        pg8::EpiProj E{ws, (unsigned char*)args.out};
        pg8::gemm_phase<pg8::EpiProj, pg8::StaticOrder, true, true>(F.lds, g, S, E);
    } SEAM(1);

    if (IN(2)) {
        const int c = F.vcu, bh = c >> 1, odd = c & 1;
        for (int i = 0; i < 4; ++i) { const int qb = odd ? (i == 0 ? 6 : i == 1 ? 1 : i == 2 ? 4 : 3) : (i == 0 ? 7 : i == 1 ? 0 : i == 2 ? 5 : 2);
            fox::attn64_unit(bh >> 3, bh & 7, qb, (const fox::bf16*)(ws + WS_FQ), (const fox::bf16*)(ws + WS_FK), (const fox::bf16*)(ws + WS_FV), (fox::bf16*)(ws + WS_FQ),
                             (const float*)(ws + WS_CB), (char*)lds); }
    }
    if (IN(3)) {
#if defined(MK_X1)
        { v4u z4 = (v4u){0u,0u,0u,0u}; for (size_t i = (size_t)F.vcu * 512 + F.tid; i < (size_t)T * 1024 / 8; i += (size_t)F.G * 512) *(GAS v4u*)((bf16*)(ws + WS_GV) + i * 8) = z4; }
        if (false)
#else
        if (F.vcu < 64)
#endif
            gla::gla_unit(F.vcu >> 2, F.vcu & 3, (const bf16*)(ws + WS_GQ), (const bf16*)(ws + WS_GK), (const bf16*)(ws + WS_GV), (const bf16*)(ws + WS_GG), (const float*)(ws + WS_GLR),
                                      I.gla_gate_up, I.gla_gate_bias, I.gla_norm_gain, (bf16*)(ws + WS_GV), F.lds);
    } SEAM(3);

    if (IN(4)) {
        pg8::Gemm g{(const pg8::bf16_t*)(ws + WS_FQ), (const pg8::bf16_t*)(ws + WS_WOF), T, Dm, 512}; pg8::StaticOrder S; S.init(T, Dm, F.G, (int)blockIdx.x);
        pg8::EpiGate<0> E{(const pg8::bf16_t*)args.out, (pg8::bf16_t*)(ws + WS_XB)};
        pg8::gemm_phase<pg8::EpiGate<0>, pg8::StaticOrder, true, true>(F.lds, g, S, E);
    } SEAM(4);
    if (IN(5)) {
        pg8::Gemm g{(const pg8::bf16_t*)(ws + WS_GV), (const pg8::bf16_t*)(ws + WS_WOG), T, Dm, Dm}; pg8::StaticOrder S; S.init(T, Dm, F.G, (int)blockIdx.x);
        pg8::EpiGate<1> E{(const pg8::bf16_t*)((unsigned char*)args.out + 64 * MiB), (pg8::bf16_t*)(ws + WS_XB)};
        pg8::gemm_phase<pg8::EpiGate<1>, pg8::StaticOrder, true, true>(F.lds, g, S, E);
    } SEAM(5);
    if (IN(6)) {
        pg8::Gemm g{(const pg8::bf16_t*)(ws + WS_XB), (const pg8::bf16_t*)(ws + WS_WO), T, Dm, Dm}; pg8::StaticOrder S; S.init(T, Dm, F.G, (int)blockIdx.x);
        pg8::EpiMix E{I.x, (float*)(ws + WS_Y)};
        pg8::gemm_phase<pg8::EpiMix, pg8::StaticOrder, true, true>(F.lds, g, S, E);
    } SEAM(6);
    if (IN(7)) { p7_ln1(F, I, ws); } SEAM(7);
    if (IN(8)) {
        pg8::Gemm g{(const pg8::bf16_t*)(ws + WS_XB), (const pg8::bf16_t*)(ws + WS_WQ), T, 2048, Dm}; pg8::StaticOrder S; S.init(T, 2048, F.G, (int)blockIdx.x);
        pg8::EpiBf16<0> E{(pg8::bf16_t*)(ws + WS_QP), 2048, nullptr, 0, 0, 1.f};
        pg8::gemm_phase<pg8::EpiBf16<0>, pg8::StaticOrder, true, true>(F.lds, g, S, E);
    } SEAM(8);
    if (IN(9)) { p9_topk(F, ws); } SEAM(9);
    if (IN(10)) { p10_experts(F, I, ws, args.out); }
#if defined(MK_TIME_A)
    xcd_barrier(bar);
    STAMP(N_PHASES);
    if (stamper_) { const unsigned long long t1 = stamps_[N_PHASES];
        const unsigned long long d = (stamps_[MK_TIME_B] - stamps_[MK_TIME_A]) * MK_TIME_K; while (rt() - t1 < d) __builtin_amdgcn_s_sleep(8); }
#endif
#undef IN
#undef SEAM
}

extern "C" void kernel_launch(void* const* d_in, const int* in_sizes, int n_in, void* d_out, int out_size, void* d_ws, size_t ws_size, hipStream_t stream) {
    static int grid = 0;
    if (grid == 0) {
        if (n_in != 17 || in_sizes[0] != T * Dm || out_size != T * Dm || ws_size < WS_END) { fprintf(stderr, "kernel_launch: unexpected shapes or workspace (n_in %d, in0 %d, out %d, ws %zu)\n", n_in, n_in > 0 ? in_sizes[0] : -1, out_size, ws_size); grid = -1; return; }
        int dev = 0, cus = 0, per_cu = 0;
        if (hipGetDevice(&dev) != hipSuccess || hipDeviceGetAttribute(&cus, hipDeviceAttributeMultiprocessorCount, dev) != hipSuccess) { grid = -1; return; }
        if (hipFuncSetAttribute((const void*)mk_fwd, hipFuncAttributeMaxDynamicSharedMemorySize, LDS_BYTES) != hipSuccess) { fprintf(stderr, "kernel_launch: hipFuncSetAttribute failed\n"); grid = -1; return; }
        if (hipOccupancyMaxActiveBlocksPerMultiprocessor(&per_cu, (const void*)mk_fwd, NWAVES * 64, LDS_BYTES) != hipSuccess || per_cu < 1) fprintf(stderr, "kernel_launch: occupancy query reports %d\n", per_cu);
        (void)hipGetLastError();
        grid = cus;
        if (grid != 256) { fprintf(stderr, "kernel_launch: built for 256 CUs, found %d\n", grid); grid = -1; return; }
    }
    if (grid < 0) return;
    if (hipMemsetAsync((char*)d_ws + WS_CTL, 0, CTL_ZERO_BYTES, stream) != hipSuccess) return;
    Args a{};
    for (int i = 0; i < 17; ++i) a.in[i] = (const float*)d_in[i];
    a.out = (float*)d_out; a.ws = (unsigned char*)d_ws;
#if MK_N_LAUNCHES == 1
    a.ph_lo = 0; a.ph_hi = N_PHASES; a.li = 0;
    hipLaunchKernelGGL(mk_fwd, dim3(grid), dim3(NWAVES * 64), LDS_BYTES, stream, a);
#else
    for (int li = 0; li < N_PHASES; ++li) { a.ph_lo = li; a.ph_hi = li + 1; a.li = li; if (li == 2) { a.ph_hi = 4; } if (li == 3) continue;
        hipLaunchKernelGGL(mk_fwd, dim3(grid), dim3(NWAVES * 64), LDS_BYTES, stream, a); }
#endif
}
```

```cpp
#include <hip/hip_runtime.h>
#include <hip/hip_bf16.h>
#include <cstdio>
#include <cstdint>
#include <cmath>
namespace pg8 {
#define PG8_LAS __attribute__((address_space(3)))
typedef unsigned short bf16_t;
typedef short bf16x8 __attribute__((ext_vector_type(8)));
typedef float f32x4 __attribute__((ext_vector_type(4)));
typedef unsigned u32x4 __attribute__((ext_vector_type(4)));
constexpr int BM = 256, BK = 64, HALF = 128, HTB = HALF * BK * 2  , STAGE_BYTES = 8 * HTB, NXCD = 8, WGM = 8;

__host__ __device__ __forceinline__ int lds_byte(int r, int c) { const int st = (r >> 4) * 2 + (c >> 5), rr = r & 15, cc = c & 31, ob = rr * 64 + cc * 2; return st * 1024 + (ob ^ (((ob >> 9) & 1) << 5)); }
__host__ __device__ __forceinline__ void stage_rc(int b, int& R, int& C) { const int st = b / 1024, sb = b % 1024, swz = sb ^ (((sb >> 9) & 1) << 5); R = (st >> 1) * 16 + swz / 64; C = (st & 1) * 32 + (swz % 64) / 2; }
__host__ __device__ __forceinline__ int perm32(int rho) { const int n = rho >> 4, i = rho & 15; return 8 * (i >> 2) + 4 * n + (i & 3); }

struct Unit { int pm, pn; };
struct Gemm { const bf16_t* A; const bf16_t* Bt; int M, N, K; };

struct StaticOrder {
    int nM, nN, nwg, G, c;
    __host__ __device__ void init(int M, int N, int G_, int c_) { nM = M / BM; nN = N / BM; nwg = nM * nN; G = G_; c = c_; }
    __host__ __device__ bool next(int i, Unit& u) const {
        const long L = (long)i * G + c; if (L >= nwg) return false;
        int wgid = (int)L; { const int q = nwg / NXCD, r = nwg % NXCD, xcd = wgid % NXCD, off = wgid / NXCD; wgid = (xcd < r ? xcd * (q + 1) : r * (q + 1) + (xcd - r) * q) + off; }
        const int nig = WGM * nN, gid = wgid / nig, fm = gid * WGM, gsz = (nM - fm) < WGM ? (nM - fm) : WGM;
        u.pm = fm + ((wgid % nig) % gsz); u.pn = (wgid % nig) / gsz; return true;
    }
    __device__ __forceinline__ void a_ready(const Unit&) const {}
    __device__ __forceinline__ void done(const Unit&) const {}
};

__device__ __forceinline__ unsigned cvt_pk_bf16(float lo, float hi) { unsigned r; asm volatile("v_cvt_pk_bf16_f32 %0, %1, %2" : "=v"(r) : "v"(lo), "v"(hi)); return r; }
typedef float f32x2 __attribute__((ext_vector_type(2)));
__device__ __forceinline__ f32x2 gelu_pk(f32x2 v) {
    const f32x2 av = __builtin_elementwise_abs(v), d = av * 0.2316418882f + 1.0f;
    f32x2 t; t.x = __builtin_amdgcn_rcpf(d.x); t.y = __builtin_amdgcn_rcpf(d.y);
    f32x2 q = t * 0.5307027145f + (-0.7265760135f); q = q * t + 0.7107068705f; q = q * t + (-0.142248368f); q = q * t + 0.127414796f; q = q * t;
    const f32x2 s = (v * v) * (-0.72134752044f);
    f32x2 e; e.x = __builtin_amdgcn_exp2f(s.x); e.y = __builtin_amdgcn_exp2f(s.y);
    const f32x2 m = v * (q * e), r = v - m;
    f32x2 o; o.x = v.x < 0.f ? m.x : r.x; o.y = v.y < 0.f ? m.y : r.y; return o;
}

template <int ACT  > struct EpiBf16 {
    static constexpr bool PERM = true, AFTER_DRAIN = false; static_assert(ACT == 0 || ACT == 1, "EpiBf16: ACT is 0 (none) or 1 (gelu_pk)");
    bf16_t* O; int ldc; const float* bias; int split_cols; size_t split_stride; float scale0;
    __device__ __forceinline__ void operator()(const f32x4 (&acc)[2][2][4][2], const Unit& u, int wr, int wc, int fr, int fq) const {
        const int row0 = u.pm * BM + wr * 64 + fr; int colt = u.pn * BM; bf16_t* base = O;
        float sc = 1.f; if (split_cols) { const int t = colt / split_cols; base += (size_t)t * split_stride; colt -= t * split_cols; if (t == 0) sc = scale0; }
        const int col0 = colt + wc * 32 + 8 * fq, bcol0 = u.pn * BM + wc * 32 + 8 * fq;
        f32x4 bv[2][2];
#pragma unroll
        for (int bj = 0; bj < 2; ++bj)
#pragma unroll
            for (int n = 0; n < 2; ++n) bv[bj][n] = bias ? *(const f32x4*)(bias + bcol0 + bj * HALF + 4 * n) : (f32x4){0.f, 0.f, 0.f, 0.f};
#pragma unroll
        for (int ai = 0; ai < 2; ++ai)
#pragma unroll
            for (int m = 0; m < 4; ++m) { bf16_t* rowp = base + (size_t)(row0 + ai * HALF + m * 16) * ldc + col0;
#pragma unroll
                for (int bj = 0; bj < 2; ++bj) { f32x4 v0 = acc[ai][bj][m][0] + bv[bj][0], v1 = acc[ai][bj][m][1] + bv[bj][1];
                    if (ACT == 1) { f32x2 a = gelu_pk((f32x2){v0[0], v0[1]}), b = gelu_pk((f32x2){v0[2], v0[3]}), c = gelu_pk((f32x2){v1[0], v1[1]}), d = gelu_pk((f32x2){v1[2], v1[3]});
                        v0 = (f32x4){a.x, a.y, b.x, b.y}; v1 = (f32x4){c.x, c.y, d.x, d.y}; }
                    v0 = v0 * sc; v1 = v1 * sc; u32x4 w; w.x = cvt_pk_bf16(v0[0], v0[1]); w.y = cvt_pk_bf16(v0[2], v0[3]); w.z = cvt_pk_bf16(v1[0], v1[1]); w.w = cvt_pk_bf16(v1[2], v1[3]);
                    *(u32x4*)(rowp + bj * HALF) = w; } }
    }
};

struct PanelStats {
    unsigned* xbuf;
    unsigned* cnt;
    unsigned* tmo;
    int ntn; float eps;
    unsigned code;
    __device__ __forceinline__ bool run(const f32x4 (&v)[2][2][4][2], const Unit& u, int wr, int wc, int fr, int fq, PG8_LAS unsigned char* lds, int wid, int lane) const {
        typedef float f32x2v __attribute__((ext_vector_type(2)));
        PG8_LAS f32x2v* P = (PG8_LAS f32x2v*)lds;
        PG8_LAS f32x2v* S = (PG8_LAS f32x2v*)(lds + 8192);
        PG8_LAS unsigned* flag = (PG8_LAS unsigned*)(lds + 8192 + 2048);
#pragma unroll
        for (int ai = 0; ai < 2; ++ai)
#pragma unroll
            for (int m = 0; m < 4; ++m) {
                float s = 0.f;
#pragma unroll
                for (int bj = 0; bj < 2; ++bj)
#pragma unroll
                    for (int n = 0; n < 2; ++n) { const f32x4 x = v[ai][bj][m][n]; s += (x[0] + x[1]) + (x[2] + x[3]); }
                s += __shfl_xor(s, 16); s += __shfl_xor(s, 32);
                const float mw = s * (1.0f / 64.0f); float q = 0.f;
#pragma unroll
                for (int bj = 0; bj < 2; ++bj)
#pragma unroll
                    for (int n = 0; n < 2; ++n) { const f32x4 d = v[ai][bj][m][n] - mw; q += (d[0] * d[0] + d[1] * d[1]) + (d[2] * d[2] + d[3] * d[3]); }
                q += __shfl_xor(q, 16); q += __shfl_xor(q, 32);
                if (fq == 0) P[(ai * HALF + wr * 64 + m * 16 + fr) * 4 + wc] = (f32x2v){mw, q};
            }
        asm volatile("s_waitcnt lgkmcnt(0)" ::: "memory"); __builtin_amdgcn_s_barrier(); asm volatile("" ::: "memory");
#if defined(BROKEN_EXCHANGE_NO_WAIT)
#warning BROKEN CONTROL BUILD: the row-statistics exchange does not wait; results are wrong by design
        if (blockIdx.x >= 64) { const long long t0_ = clock64(); while (clock64() - t0_ < 60000) __builtin_amdgcn_s_sleep(8); }
#endif
        const int row = wid * 32 + (lane & 31);
        if (lane < 32) {
            const f32x2v a = P[row * 4 + 0], b = P[row * 4 + 1], c = P[row * 4 + 2], d = P[row * 4 + 3];
            const float mt = (a.x + b.x + c.x + d.x) * 0.25f;
            const float da = a.x - mt, db = b.x - mt, dc = c.x - mt, dd = d.x - mt;
            const float m2 = (a.y + b.y) + (c.y + d.y) + 64.0f * ((da * da + db * db) + (dc * dc + dd * dd));
            unsigned long long* slot = (unsigned long long*)xbuf + ((size_t)(u.pm * BM + row) * 4 + u.pn);
            __hip_atomic_store(slot, ((unsigned long long)__float_as_uint(m2) << 32) | __float_as_uint(mt), __ATOMIC_RELAXED, __HIP_MEMORY_SCOPE_AGENT);
        }
        asm volatile("s_waitcnt vmcnt(0)" ::: "memory");
        if (lane == 0) __hip_atomic_fetch_add(cnt + 64 * u.pm, 1u, __ATOMIC_RELAXED, __HIP_MEMORY_SCOPE_AGENT);
        if (wid == 0) {
            bool dead = false; const unsigned long long t0 = __builtin_amdgcn_s_memrealtime(); const unsigned want = 8u * (unsigned)ntn;
            for (;;) {
#if defined(BROKEN_EXCHANGE_NO_WAIT)
                break;
#endif
                if ((unsigned)__builtin_amdgcn_readfirstlane(__hip_atomic_load(cnt + 64 * u.pm, __ATOMIC_RELAXED, __HIP_MEMORY_SCOPE_AGENT)) >= want) break;
                if (__builtin_amdgcn_s_memrealtime() - t0 > 2000000ull) {
                    if (lane == 0) { unsigned expect = 0u; __hip_atomic_compare_exchange_strong(tmo + 1, &expect, code | (unsigned)(u.pm & 0xff), __ATOMIC_RELAXED, __ATOMIC_RELAXED, __HIP_MEMORY_SCOPE_AGENT);
                                     __hip_atomic_store(tmo, 1u, __ATOMIC_RELAXED, __HIP_MEMORY_SCOPE_AGENT); }
                    dead = true; break; }
                __builtin_amdgcn_s_sleep(2);
            }
            __builtin_amdgcn_fence(__ATOMIC_ACQUIRE, "agent");
            if (lane == 0) flag[0] = dead ? 1u : 0u;
        }
        asm volatile("s_waitcnt vmcnt(0) lgkmcnt(0)" ::: "memory"); __builtin_amdgcn_s_barrier(); asm volatile("" ::: "memory");
        const bool bad = flag[0] != 0u;
        if (lane < 32) {
            const unsigned long long* slot = (const unsigned long long*)xbuf + (size_t)(u.pm * BM + row) * 4; float mt[4], m2[4]; float ms = 0.f;
#pragma unroll
            for (int t = 0; t < 4; ++t) { if (t < ntn) { const unsigned long long w = __hip_atomic_load(slot + t, __ATOMIC_RELAXED, __HIP_MEMORY_SCOPE_AGENT); mt[t] = __uint_as_float((unsigned)w); m2[t] = __uint_as_float((unsigned)(w >> 32)); } else { mt[t] = 0.f; m2[t] = 0.f; } ms += mt[t]; }
            const float mean = ms / (float)ntn; float q = 0.f;
#pragma unroll
            for (int t = 0; t < 4; ++t) if (t < ntn) { const float dm = mt[t] - mean; q += m2[t] + 256.0f * dm * dm; }
            S[row] = (f32x2v){mean, 1.0f / sqrtf(q / (256.0f * (float)ntn) + eps)};
        }
        asm volatile("s_waitcnt lgkmcnt(0)" ::: "memory"); __builtin_amdgcn_s_barrier(); asm volatile("" ::: "memory");
        return bad;
    }
};
struct EpiLnRes {
    static constexpr bool PERM = false, AFTER_DRAIN = true;
    const float* base; float* out; int ldc; const float* bias; PanelStats st; unsigned poison;
    __device__ __forceinline__ void fused(f32x4 (&acc)[2][2][4][2], const Unit& u, int wr, int wc, int fr, int fq, PG8_LAS unsigned char* lds, int wid, int lane) const {
        typedef float f32x2v __attribute__((ext_vector_type(2)));
        const PG8_LAS f32x2v* S = (const PG8_LAS f32x2v*)(lds + 8192);
        const int col0 = u.pn * BM + wc * 32 + 4 * fq;
#pragma unroll
        for (int bj = 0; bj < 2; ++bj)
#pragma unroll
            for (int n = 0; n < 2; ++n) { const f32x4 bv = bias ? *(const f32x4*)(bias + col0 + bj * HALF + n * 16) : (f32x4){0.f, 0.f, 0.f, 0.f};
#pragma unroll
                for (int ai = 0; ai < 2; ++ai)
#pragma unroll
                    for (int m = 0; m < 4; ++m) acc[ai][bj][m][n] += bv; }
        f32x4 pre[4][2][2];
#pragma unroll
        for (int m = 0; m < 4; ++m) { const size_t off = (size_t)(u.pm * BM + wr * 64 + m * 16 + fr) * ldc + col0;
#pragma unroll
            for (int bj = 0; bj < 2; ++bj)
#pragma unroll
                for (int n = 0; n < 2; ++n) pre[m][bj][n] = *(const f32x4*)(base + off + bj * HALF + n * 16); }
        const bool bad = st.run(acc, u, wr, wc, fr, fq, lds, wid, lane) || poison != 0u;
        const float qnan = __builtin_nanf("");
#pragma unroll
        for (int ai = 0; ai < 2; ++ai)
#pragma unroll
            for (int m = 0; m < 4; ++m) { const int r = ai * HALF + wr * 64 + m * 16 + fr; const f32x2v sr = S[r]; const size_t off = (size_t)(u.pm * BM + r) * ldc + col0;
#pragma unroll
                for (int bj = 0; bj < 2; ++bj)
#pragma unroll
                    for (int n = 0; n < 2; ++n) { const f32x4 bs = ai == 0 ? pre[m][bj][n] : *(const f32x4*)(base + off + bj * HALF + n * 16); f32x4 o = bs + (acc[ai][bj][m][n] - sr.x) * sr.y;
                        if (bad) o = (f32x4){qnan, qnan, qnan, qnan}; *(f32x4*)(out + off + bj * HALF + n * 16) = o; }
                if (m & 1) asm volatile("" ::: "memory"); }
    }
};
struct EpiLnResLn {
    static constexpr bool PERM = false, AFTER_DRAIN = true;
    const float* base; float* out; bf16_t* xn; int ldc; const float* bias; PanelStats st1, st2; unsigned poison;
    __device__ __forceinline__ void fused(f32x4 (&acc)[2][2][4][2], const Unit& u, int wr, int wc, int fr, int fq, PG8_LAS unsigned char* lds, int wid, int lane) const {
        typedef float f32x2v __attribute__((ext_vector_type(2))); typedef unsigned u32x2v __attribute__((ext_vector_type(2)));
        const PG8_LAS f32x2v* S = (const PG8_LAS f32x2v*)(lds + 8192);
        const int col0 = u.pn * BM + wc * 32 + 4 * fq;
#pragma unroll
        for (int bj = 0; bj < 2; ++bj)
#pragma unroll
            for (int n = 0; n < 2; ++n) { const f32x4 bv = bias ? *(const f32x4*)(bias + col0 + bj * HALF + n * 16) : (f32x4){0.f, 0.f, 0.f, 0.f};
#pragma unroll
                for (int ai = 0; ai < 2; ++ai)
#pragma unroll
                    for (int m = 0; m < 4; ++m) acc[ai][bj][m][n] += bv; }
        bool bad = st1.run(acc, u, wr, wc, fr, fq, lds, wid, lane) || poison != 0u;
        const float qnan = __builtin_nanf("");
#pragma unroll
        for (int ai = 0; ai < 2; ++ai)
#pragma unroll
            for (int m = 0; m < 4; ++m) { const int r = ai * HALF + wr * 64 + m * 16 + fr; const f32x2v sr = S[r]; const size_t off = (size_t)(u.pm * BM + r) * ldc + col0;
#pragma unroll
                for (int bj = 0; bj < 2; ++bj)
#pragma unroll
                    for (int n = 0; n < 2; ++n) { const f32x4 bs = *(const f32x4*)(base + off + bj * HALF + n * 16); acc[ai][bj][m][n] = bs + (acc[ai][bj][m][n] - sr.x) * sr.y; }
                asm volatile("" : "+v"(acc[ai][0][m][0]), "+v"(acc[ai][0][m][1]), "+v"(acc[ai][1][m][0]), "+v"(acc[ai][1][m][1]));
                if (m & 1) asm volatile("" ::: "memory"); }
        const bool bad1 = bad;
        bad = st2.run(acc, u, wr, wc, fr, fq, lds, wid, lane) || bad;
#pragma unroll
        for (int ai = 0; ai < 2; ++ai)
#pragma unroll
            for (int m = 0; m < 4; ++m) { const int r = ai * HALF + wr * 64 + m * 16 + fr; const f32x2v sr = S[r]; const size_t off = (size_t)(u.pm * BM + r) * ldc + col0;
#pragma unroll
                for (int bj = 0; bj < 2; ++bj)
#pragma unroll
                    for (int n = 0; n < 2; ++n) { const f32x4 x1 = acc[ai][bj][m][n]; *(f32x4*)(out + off + bj * HALF + n * 16) = bad1 ? (f32x4){qnan, qnan, qnan, qnan} : x1;
                        const f32x4 o = (x1 - sr.x) * sr.y; u32x2v w; w.x = cvt_pk_bf16(o[0], o[1]); w.y = cvt_pk_bf16(o[2], o[3]);
                        if (bad) { w.x = 0x7fc07fc0u; w.y = 0x7fc07fc0u; } *(u32x2v*)(xn + off + bj * HALF + n * 16) = w; }
                asm volatile("" ::: "memory"); }
    }
};

template <class Epi, class Sched, bool ALIGN_EPI = false, bool SP2 = false>
__device__ __forceinline__ void gemm_phase(PG8_LAS unsigned char* lds, const Gemm g, const Sched& S, const Epi& E) {
    const int tid = threadIdx.x, wid = __builtin_amdgcn_readfirstlane(tid >> 6), lane = tid & 63, wr = wid >> 2, wc = wid & 3, fr = lane & 15, fq = lane >> 4;
    const int K = g.K, nt = K / BK;
    unsigned voffA[2], voffB[2];
#pragma unroll
    for (int i = 0; i < 2; ++i) { int R, C; stage_rc(tid * 16 + i * 8192, R, C); const int Rb = Epi::PERM ? ((R & ~31) + perm32(R & 31)) : R;
        voffA[i] = (unsigned)(R * K + C) * 2u; voffB[i] = (unsigned)(Rb * K + C) * 2u; }
    const size_t kstep = (size_t)(BK * 2);
    const size_t hstep = (size_t)HALF * K * 2;
    const size_t tstep = 2 * hstep;
    const unsigned ldsw = (unsigned)wid * 1024u;
    const int aoff = lds_byte(wr * 64 + fr, fq * 8), boff = lds_byte(wc * 32 + fr, fq * 8);
#define PG8_SA(b, h) (((b) * 2 + (h)) * HTB)
#define PG8_SB(b, h) ((4 + (b) * 2 + (h)) * HTB)
#define PG8_STAGE(bufoff, gbase, voff) do { _Pragma("unroll") for (int _i = 0; _i < 2; ++_i) \
        __builtin_amdgcn_global_load_lds((const unsigned*)((const char*)(gbase) + (voff)[_i]), (PG8_LAS unsigned*)(lds + (bufoff) + ldsw + _i * 8192), 16, 0, 0); } while (0)
#define PG8_LDA(dst, b, h) do { _Pragma("unroll") for (int m = 0; m < 4; ++m) _Pragma("unroll") for (int k = 0; k < 2; ++k) dst[m][k] = *(const PG8_LAS bf16x8*)(lds + PG8_SA(b, h) + aoff + m * 2048 + k * 1024); } while (0)
#define PG8_LDB(dst, b, h) do { _Pragma("unroll") for (int n = 0; n < 2; ++n) _Pragma("unroll") for (int k = 0; k < 2; ++k) dst[n][k] = *(const PG8_LAS bf16x8*)(lds + PG8_SB(b, h) + boff + n * 2048 + k * 1024); } while (0)
#define PG8_MMA(ai, bj, At, Bt) do { __builtin_amdgcn_s_setprio(1); _Pragma("unroll") for (int m = 0; m < 4; ++m) _Pragma("unroll") for (int n = 0; n < 2; ++n) _Pragma("unroll") for (int k = 0; k < 2; ++k) \
        acc[ai][bj][m][n] = __builtin_amdgcn_mfma_f32_16x16x32_bf16(Bt[n][k], At[m][k], acc[ai][bj][m][n], 0, 0, 0); __builtin_amdgcn_s_setprio(0); } while (0)
#define PG8_WAIT_V(n) asm volatile("s_waitcnt vmcnt(" #n ")" ::: "memory")
#define PG8_WAIT_L(n) asm volatile("s_waitcnt lgkmcnt(" #n ")" ::: "memory")
#define PG8_BAR __builtin_amdgcn_s_barrier()
#define PG8_SCHED __builtin_amdgcn_sched_barrier(0)
    Unit cur, nxt; int ui = 0;
    if (!S.next(0, cur)) return;
    f32x4 acc[2][2][4][2];
#pragma unroll
    for (int a = 0; a < 2; ++a)
#pragma unroll
        for (int b = 0; b < 2; ++b)
#pragma unroll
            for (int m = 0; m < 4; ++m)
#pragma unroll
                for (int n = 0; n < 2; ++n) acc[a][b][m][n] = (f32x4){0.f, 0.f, 0.f, 0.f};
    bf16x8 At[4][2], B0[2][2], B1[2][2];
    const char* cA = (const char*)g.A + (size_t)cur.pm * tstep; const char* cB = (const char*)g.Bt + (size_t)cur.pn * tstep;
    S.a_ready(cur);
    if constexpr (SP2) {
        PG8_STAGE(PG8_SB(0, 0), cB, voffB); PG8_STAGE(PG8_SB(0, 1), cB + hstep, voffB); PG8_STAGE(PG8_SA(0, 0), cA, voffA); PG8_STAGE(PG8_SA(0, 1), cA + hstep, voffA);
        if (wr == 1) PG8_BAR;
        PG8_WAIT_V(2); PG8_BAR;
        PG8_STAGE(PG8_SB(1, 0), cB + kstep, voffB); PG8_STAGE(PG8_SA(1, 0), cA + kstep, voffA); PG8_STAGE(PG8_SB(1, 1), cB + hstep + kstep, voffB);
        PG8_WAIT_V(6); PG8_BAR;
    } else {
        PG8_STAGE(PG8_SB(0, 0), cB, voffB); PG8_STAGE(PG8_SA(0, 0), cA, voffA); PG8_STAGE(PG8_SB(0, 1), cB + hstep, voffB); PG8_STAGE(PG8_SA(0, 1), cA + hstep, voffA);
        if (wr == 1) PG8_BAR;
        PG8_WAIT_V(4); PG8_BAR;
        PG8_STAGE(PG8_SB(1, 0), cB + kstep, voffB); PG8_STAGE(PG8_SA(1, 0), cA + kstep, voffA); PG8_STAGE(PG8_SB(1, 1), cB + hstep + kstep, voffB);
        PG8_WAIT_V(6); PG8_BAR;
    }
    for (;;) {
        const bool has_next = S.next(ui + 1, nxt);
        const char* nA = has_next ? (const char*)g.A + (size_t)nxt.pm * tstep : cA; const char* nB = has_next ? (const char*)g.Bt + (size_t)nxt.pn * tstep : cB;
        for (int t = 0; t < nt; t += 2) {
            const bool last = (t == nt - 2);
            const char* a1 = cA + (size_t)(t + 1) * kstep;
            const char* a2 = last ? nA : cA + (size_t)(t + 2) * kstep; const char* b2 = last ? nB : cB + (size_t)(t + 2) * kstep;
            const char* a3 = a2 + kstep; const char* b3 = b2 + kstep;
            if (last && has_next) S.a_ready(nxt);
            if constexpr (SP2) {
            PG8_LDB(B0, 0, 0); PG8_LDB(B1, 0, 1); PG8_SCHED; PG8_LDA(At, 0, 0); PG8_STAGE(PG8_SA(1, 1), a1 + hstep, voffA);
            PG8_WAIT_V(8); PG8_WAIT_L(0); PG8_BAR; PG8_MMA(0, 0, At, B0); PG8_MMA(0, 1, At, B1); PG8_BAR; PG8_SCHED;
            PG8_LDA(At, 0, 1); PG8_STAGE(PG8_SB(0, 0), b2, voffB); PG8_STAGE(PG8_SB(0, 1), b2 + hstep, voffB); PG8_STAGE(PG8_SA(0, 0), a2, voffA);
            PG8_WAIT_V(8); PG8_WAIT_L(0); PG8_BAR; PG8_MMA(1, 0, At, B0); PG8_MMA(1, 1, At, B1); PG8_BAR; PG8_SCHED;
            PG8_LDB(B0, 1, 0); PG8_LDB(B1, 1, 1); PG8_SCHED; PG8_LDA(At, 1, 0); PG8_STAGE(PG8_SA(0, 1), a2 + hstep, voffA);
            PG8_WAIT_V(8); PG8_WAIT_L(0); PG8_BAR; PG8_MMA(0, 0, At, B0); PG8_MMA(0, 1, At, B1); PG8_BAR; PG8_SCHED;
            PG8_LDA(At, 1, 1); PG8_STAGE(PG8_SB(1, 0), b3, voffB); PG8_STAGE(PG8_SB(1, 1), b3 + hstep, voffB); PG8_STAGE(PG8_SA(1, 0), a3, voffA);
            PG8_WAIT_V(8); PG8_WAIT_L(0); PG8_BAR; PG8_MMA(1, 0, At, B0); PG8_MMA(1, 1, At, B1); PG8_BAR; PG8_SCHED;
            } else {
            PG8_LDB(B0, 0, 0); PG8_SCHED; PG8_LDA(At, 0, 0); PG8_STAGE(PG8_SA(1, 1), a1 + hstep, voffA);
            PG8_WAIT_L(8); PG8_BAR; PG8_WAIT_L(0); PG8_MMA(0, 0, At, B0); PG8_BAR; PG8_SCHED;
            PG8_LDB(B1, 0, 1); PG8_STAGE(PG8_SB(0, 0), b2, voffB);
            PG8_BAR; PG8_WAIT_L(0); PG8_MMA(0, 1, At, B1); PG8_BAR;
            PG8_LDA(At, 0, 1); PG8_STAGE(PG8_SA(0, 0), a2, voffA);
            PG8_BAR; PG8_WAIT_L(0); PG8_MMA(1, 0, At, B0); PG8_BAR; PG8_SCHED;
            PG8_STAGE(PG8_SB(0, 1), b2 + hstep, voffB);
            PG8_WAIT_V(6); PG8_BAR; PG8_MMA(1, 1, At, B1); PG8_BAR;
            PG8_LDB(B0, 1, 0); PG8_SCHED; PG8_LDA(At, 1, 0); PG8_STAGE(PG8_SA(0, 1), a2 + hstep, voffA);
            PG8_WAIT_L(8); PG8_BAR; PG8_WAIT_L(0); PG8_MMA(0, 0, At, B0); PG8_BAR; PG8_SCHED;
            PG8_LDB(B1, 1, 1); PG8_STAGE(PG8_SB(1, 0), b3, voffB);
            PG8_BAR; PG8_WAIT_L(0); PG8_MMA(0, 1, At, B1); PG8_BAR;
            PG8_LDA(At, 1, 1); PG8_STAGE(PG8_SA(1, 0), a3, voffA);
            PG8_BAR; PG8_WAIT_L(0); PG8_MMA(1, 0, At, B0); PG8_BAR; PG8_SCHED;
            PG8_STAGE(PG8_SB(1, 1), b3 + hstep, voffB);
            PG8_WAIT_V(6); PG8_BAR; PG8_MMA(1, 1, At, B1); PG8_BAR;
            }
        }
        if constexpr (ALIGN_EPI) { if (wr == 0) PG8_BAR; }
        if constexpr (!Epi::AFTER_DRAIN) { E(acc, cur, wr, wc, fr, fq); S.done(cur); }
        if (!has_next) break;
#pragma unroll
        for (int a = 0; a < 2; ++a)
#pragma unroll
            for (int b = 0; b < 2; ++b)
#pragma unroll
                for (int m = 0; m < 4; ++m)
#pragma unroll
                    for (int n = 0; n < 2; ++n) acc[a][b][m][n] = (f32x4){0.f, 0.f, 0.f, 0.f};
        cur = nxt; cA = nA; cB = nB; ++ui;
        if constexpr (ALIGN_EPI) { if (wr == 1) PG8_BAR; }
    }
    PG8_WAIT_V(0);
    if constexpr (!ALIGN_EPI) { if (wr == 0) PG8_BAR; }
    PG8_BAR;
    if constexpr (Epi::AFTER_DRAIN) { E.fused(acc, cur, wr, wc, fr, fq, lds, wid, lane); S.done(cur); }
#undef PG8_SA
#undef PG8_SB
#undef PG8_STAGE
#undef PG8_LDA
#undef PG8_LDB
#undef PG8_MMA
#undef PG8_WAIT_V
#undef PG8_WAIT_L
#undef PG8_BAR
#undef PG8_SCHED
}
}
#define GAS __attribute__((address_space(1)))
#define LAS __attribute__((address_space(3)))
typedef unsigned short bf16;
typedef unsigned v4u __attribute__((ext_vector_type(4)));
typedef float f32x4 __attribute__((ext_vector_type(4)));
typedef short bf16x8 __attribute__((ext_vector_type(8)));
typedef GAS unsigned gu32;
typedef GAS unsigned long long gu64;
#define RLX_AGENT __ATOMIC_RELAXED, __HIP_MEMORY_SCOPE_AGENT
#define LDS_WAIT() asm volatile("s_waitcnt lgkmcnt(0)" ::: "memory")
#define VM_WAIT() asm volatile("s_waitcnt vmcnt(0)" ::: "memory")
__device__ __forceinline__ unsigned long long rt() { return __builtin_amdgcn_s_memrealtime(); }
__device__ __forceinline__ unsigned f2bf(float f) { unsigned u = __builtin_bit_cast(unsigned, f); return (u + 0x7fffu + ((u >> 16) & 1u)) >> 16; }
__device__ __forceinline__ unsigned pk2(float lo, float hi) { return f2bf(lo) | (f2bf(hi) << 16); }

#define XB_TMO      128
#define XB_XCNT(j)  (256  + 64 * (j))
#define XB_XSUB(j)  (1280 + 64 * (j))
#define XB_XGEN(j)  (2304 + 64 * (j))
#define XB_TOP      3328
#define XB_TOPGEN   3392
#define XCD_BAR_WORDS 3456
#define XB_SPIN_CAP (1u << 22)

__device__ __forceinline__ unsigned xb_ld(unsigned* p)              { return __hip_atomic_load(p, __ATOMIC_RELAXED, __HIP_MEMORY_SCOPE_AGENT); }
__device__ __forceinline__ unsigned xb_add(unsigned* p, unsigned v) { return __hip_atomic_fetch_add(p, v, __ATOMIC_RELAXED, __HIP_MEMORY_SCOPE_AGENT); }
__device__ __forceinline__ unsigned xb_xcc_id() { return (unsigned)__builtin_amdgcn_s_getreg((3 << 11) | 20) & 0xFu; }
#define XB_SPIN(cond, bar) do { unsigned _sp = 0; while (cond) { __builtin_amdgcn_s_sleep(1); \
    if ((++_sp & 255u) == 0u) { if (xb_ld(&(bar)[XB_TMO])) break; if (_sp > XB_SPIN_CAP) { atomicAdd(&(bar)[XB_TMO], 1u); break; } } } } while (0)

struct XcdBarrier {
    unsigned* bar; unsigned x;
    volatile LAS unsigned* st;
};

__device__ __forceinline__ XcdBarrier xcd_barrier_post(unsigned* bar, volatile LAS unsigned* st) {
    XcdBarrier b; b.bar = bar; b.x = xb_xcc_id(); b.st = st;
    if (threadIdx.x == 0) (void)xb_add(&bar[XB_XCNT(b.x)], 1u);
    return b;
}
__device__ __forceinline__ void xcd_barrier_complete(unsigned* bar, unsigned x, unsigned& nloc, unsigned& nx) {
    const unsigned G = gridDim.x * gridDim.y * gridDim.z;
    unsigned sum, cnt, mine, sp = 0u;
    for (;;) {
        sum = 0u; cnt = 0u; mine = 0u;
#pragma unroll
        for (unsigned j = 0; j < 16; ++j) { const unsigned c = xb_ld(&bar[XB_XCNT(j)]); sum += c; cnt += (c > 0u) ? 1u : 0u; mine = (j == x) ? c : mine; }
        if (sum == G) break;
        __builtin_amdgcn_s_sleep(1);
        if ((++sp & 255u) == 0u) { if (xb_ld(&bar[XB_TMO])) break; if (sp > XB_SPIN_CAP) { atomicAdd(&bar[XB_TMO], 1u); break; } }
    }
    nloc = mine > 0u ? mine : 1u; nx = cnt > 0u ? cnt : 1u;
}

__device__ __forceinline__ void xcd_barrier(const XcdBarrier& b) {
    asm volatile("s_waitcnt vmcnt(0)" ::: "memory");
    __syncthreads();
    if (threadIdx.x == 0) {
        unsigned* bar = b.bar;
        __builtin_amdgcn_s_waitcnt(0);
        unsigned nloc = b.st[0], nx = b.st[1];
        if (nloc == 0u) { xcd_barrier_complete(bar, b.x, nloc, nx); b.st[0] = nloc; b.st[1] = nx; }
        const unsigned old = xb_add(&bar[XB_XSUB(b.x)], 1u);
        const unsigned gen = old / nloc;
        if (old + 1u == (gen + 1u) * nloc) {
            __builtin_amdgcn_fence(__ATOMIC_RELEASE, "agent");
            asm volatile("s_waitcnt vmcnt(0)" ::: "memory");
            const unsigned og = xb_add(&bar[XB_TOP], 1u);
            const unsigned tg = og / nx;
            if (og + 1u == (tg + 1u) * nx) xb_add(&bar[XB_TOPGEN], 1u);
            else XB_SPIN(xb_ld(&bar[XB_TOPGEN]) == tg, bar);
            __builtin_amdgcn_fence(__ATOMIC_ACQUIRE, "agent");
            xb_add(&bar[XB_XGEN(b.x)], 1u);
            asm volatile("s_waitcnt vmcnt(0)" ::: "memory");
        } else {
            XB_SPIN(xb_ld(&bar[XB_XGEN(b.x)]) == gen, bar);
            __builtin_amdgcn_fence(__ATOMIC_ACQUIRE, "agent");
            asm volatile("s_waitcnt vmcnt(0)" ::: "memory");
        }
    }
    __syncthreads();
}

namespace fox {
using bf16 = __hip_bfloat16;
using bf16x8 = __attribute__((ext_vector_type(8))) short;
using s16x4 = __attribute__((ext_vector_type(4))) short;
using f32x16 = __attribute__((ext_vector_type(16))) float;
using u32x4 = __attribute__((ext_vector_type(4))) unsigned;
using f32x4v = __attribute__((ext_vector_type(4))) float;
constexpr int BATCH = 16, NHEAD = 8, SEQ = 2048, D = 64, DM = NHEAD * D;
constexpr int NW = 8, QBLK = 32, QB = QBLK * NW, KVBLK = 64, NQB = SEQ / QB;
constexpr float C2 = 0.125f * 1.4426950408889634f;
constexpr int SLOTB = 8192, LDS_K = 0, LDS_V = 3 * SLOTB, LDS_WS = 6 * SLOTB, LDS_OST = LDS_WS + NW * 256, LDS_CB = LDS_OST + NW * 4096, LDS_BYTES = LDS_CB + SEQ * 4;
#define SBAR() __builtin_amdgcn_sched_barrier(0)
#define PIN(x) asm volatile("" : "+v"(x))
#define MFMA(a, b, c) __builtin_amdgcn_mfma_f32_32x32x16_bf16(a, b, c, 0, 0, 0)
#define WAIT_BAR(N) asm volatile("s_waitcnt vmcnt(" #N ") lgkmcnt(0)\n\ts_barrier" ::: "memory")

__device__ __forceinline__ int crow(int r, int hi) { return (r & 3) + 8 * (r >> 2) + 4 * hi; }
__device__ __forceinline__ unsigned cvtpk(float lo, float hi) { unsigned r; asm("v_cvt_pk_bf16_f32 %0, %1, %2" : "=v"(r) : "v"(lo), "v"(hi)); return r; }
__device__ __forceinline__ void glds16(const void* g, unsigned lds_base) {
    unsigned sv; asm volatile("s_mov_b32 %0, m0\n\ts_mov_b32 m0, %2\n\ts_nop 0\n\tglobal_load_lds_dwordx4 %1, off\n\ts_mov_b32 m0, %0" : "=&s"(sv) : "v"(g), "s"(lds_base) : "memory"); }
typedef __attribute__((address_space(3))) const char* lds_cptr;
typedef short v4i16_t __attribute__((ext_vector_type(4)));
__device__ __forceinline__ void kload2(bf16x8* kf, lds_cptr kp, int d0) { kf[2 * d0] = *(const __attribute__((address_space(3))) bf16x8*)(kp + d0 * 2048); kf[2 * d0 + 1] = *(const __attribute__((address_space(3))) bf16x8*)(kp + d0 * 2048 + 512); }
__device__ __forceinline__ s16x4 vtr(lds_cptr p) { return __builtin_bit_cast(s16x4, __builtin_amdgcn_ds_read_tr16_b64_v4i16((__attribute__((address_space(3))) v4i16_t*)p)); }
#define MX3(a, b, c) __builtin_fmaxf(__builtin_fmaxf((a), (b)), (c))
__device__ __forceinline__ float rowmax(const f32x16& p0, const f32x16& p1) {
    float a = MX3(p0[0], p0[1], p1[0]), b = MX3(p0[2], p0[3], p1[1]); a = MX3(a, p1[2], p1[3]);
#pragma unroll
    for (int r = 4; r < 16; r += 4) { a = MX3(a, p0[r], p0[r + 1]); b = MX3(b, p0[r + 2], p0[r + 3]); a = MX3(a, p1[r], p1[r + 1]); b = MX3(b, p1[r + 2], p1[r + 3]); }
    float m = __builtin_fmaxf(a, b); auto rr = __builtin_amdgcn_permlane32_swap(__float_as_uint(m), __float_as_uint(m), false, false);
    return __builtin_fmaxf(__uint_as_float(rr[0]), __uint_as_float(rr[1])); }
__device__ __forceinline__ void cmask(f32x16& p0, f32x16& p1, int jb, int qrel, int hi) {
    const int kb = 64 * jb + 4 * hi;
#pragma unroll
    for (int r = 0; r < 16; ++r) { const int kv = kb + (r & 3) + 8 * (r >> 2); if (kv > qrel) p0[r] = -INFINITY; if (kv + 32 > qrel) p1[r] = -INFINITY; } }

__device__ __forceinline__ void attn64_unit(int b, int h, int qb, const bf16* Q, const bf16* __restrict__ K, const bf16* __restrict__ V, bf16* O, const float* __restrict__ CBg, char* lds) {
    const int tid = threadIdx.x, lane = tid & 63, r32 = lane & 31, hi = lane >> 5; const int wid = __builtin_amdgcn_readfirstlane(tid >> 6);
    const long rowbase = (long)b * SEQ; const int q0 = qb * QB, NT = (q0 + QB) / KVBLK;
    const bf16* Qw = Q + (rowbase + q0 + wid * QBLK) * DM + h * D;
    const unsigned lds0 = (unsigned)(uintptr_t)lds; float* wsf = (float*)(lds + LDS_WS) + wid * 64;
    const bf16* ksrc = K + rowbase * DM + h * D + (long)lane * DM + wid * 8;
    const bf16* vsrc = V + rowbase * DM + h * D + (long)(16 * (wid & 3) + (lane >> 2)) * DM + (wid >> 2) * 32 + (lane & 3) * 8;
    const unsigned kdst = lds0 + LDS_K + wid * 1024, vdst = lds0 + LDS_V + wid * 1024;
#define DMA_K(t, slot) glds16(ksrc + (long)(t) * KVBLK * DM, (unsigned)__builtin_amdgcn_readfirstlane(kdst + (slot)))
#define DMA_V(t, slot) glds16(vsrc + (long)(t) * KVBLK * DM, (unsigned)__builtin_amdgcn_readfirstlane(vdst + (slot)))
    const lds_cptr vp0 = (lds_cptr)lds + LDS_V + ((lane >> 4) & 1) * 32 + (lane & 3) * 8 + (4 * hi + ((lane & 15) >> 2)) * 64;
    const lds_cptr kp0 = (lds_cptr)lds + LDS_K + hi * 1024 + r32 * 16;
    const bool cb_mine = (4 * tid < NT * KVBLK); f32x4v cbv = (f32x4v){0.f, 0.f, 0.f, 0.f};
    if (cb_mine) cbv = *(const f32x4v*)(CBg + (long)(b * NHEAD + h) * SEQ + 4 * tid);
    DMA_K(0, 0); DMA_V(0, 0); DMA_K(1, SLOTB);
    bf16x8 qr[4];
#pragma unroll
    for (int d0 = 0; d0 < 4; ++d0) qr[d0] = *reinterpret_cast<const bf16x8*>(&Qw[(long)r32 * DM + d0 * 16 + hi * 8]);
    float mhat = 0.f, l_reg = 0.f; f32x16 o[2]; o[0] = f32x16{}; o[1] = f32x16{};
    const lds_cptr cbp0 = (lds_cptr)lds + LDS_CB + hi * 16;
#define LDBIAS(P0_, P1_, t_) do { const lds_cptr cq_ = cbp0 + (t_) * 256; _Pragma("unroll") for (int g_ = 0; g_ < 4; ++g_) { \
        const f32x4v a_ = *(const __attribute__((address_space(3))) f32x4v*)(cq_ + g_ * 32), b_ = *(const __attribute__((address_space(3))) f32x4v*)(cq_ + 128 + g_ * 32); \
        P0_[4 * g_] = a_[0]; P0_[4 * g_ + 1] = a_[1]; P0_[4 * g_ + 2] = a_[2]; P0_[4 * g_ + 3] = a_[3]; P1_[4 * g_] = b_[0]; P1_[4 * g_ + 1] = b_[1]; P1_[4 * g_ + 2] = b_[2]; P1_[4 * g_ + 3] = b_[3]; } } while (0)
#define LDBIAS2(G_, P0_, P1_, t_, g_) do { if (G_) { const lds_cptr cq_ = cbp0 + (t_) * 256; \
        const f32x4v a_ = *(const __attribute__((address_space(3))) f32x4v*)(cq_ + (g_) * 32), b_ = *(const __attribute__((address_space(3))) f32x4v*)(cq_ + 128 + (g_) * 32); \
        P0_[4 * (g_)] = a_[0]; P0_[4 * (g_) + 1] = a_[1]; P0_[4 * (g_) + 2] = a_[2]; P0_[4 * (g_) + 3] = a_[3]; P1_[4 * (g_)] = b_[0]; P1_[4 * (g_) + 1] = b_[1]; P1_[4 * (g_) + 2] = b_[2]; P1_[4 * (g_) + 3] = b_[3]; SBAR(); } } while (0)
    const int qrel = wid * QBLK + r32; bool resc = false;
    f32x16 pA0, pA1, pB0, pB1; bf16x8 kf[8]; s16x4 vlo[8], vhi[8]; u32x4 pw0, pw1, pw2, pw3;
    int sl_prev = 0, sl_cur = 0, sl_next = SLOTB;
#define ROT() do { sl_prev = sl_cur; sl_cur = sl_next; sl_next = (sl_next == 2 * SLOTB) ? 0 : sl_next + SLOTB; } while (0)
#define EX(v) __builtin_amdgcn_exp2f(__builtin_fmaf((v), C2, nmh))
#define RESC() do { if (resc) { _Pragma("unroll") for (int d_ = 0; d_ < 2; ++d_) _Pragma("unroll") for (int r = 0; r < 16; ++r) o[d_][r] *= wsf[crow(r, hi)]; } } while (0)
    DMA_K(2, 2 * SLOTB);
    if (cb_mine) *(__attribute__((address_space(3))) f32x4v*)((lds_cptr)lds + LDS_CB + 16 * tid) = cbv;
    WAIT_BAR(3);
    _Pragma("unroll") for (int d0 = 0; d0 < 4; ++d0) kload2(kf, kp0, d0);
    LDBIAS(pA0, pA1, 0);
    pA0 = MFMA(kf[0], qr[0], pA0); pA1 = MFMA(kf[1], qr[0], pA1); pA0 = MFMA(kf[2], qr[1], pA0); pA1 = MFMA(kf[3], qr[1], pA1);
    pA0 = MFMA(kf[4], qr[2], pA0); pA1 = MFMA(kf[5], qr[2], pA1); pA0 = MFMA(kf[6], qr[3], pA0); pA1 = MFMA(kf[7], qr[3], pA1);
    if (NT == 4) cmask(pA0, pA1, 0, qrel, hi);
    { const float rm = rowmax(pA0, pA1); mhat = rm * C2; const float nmh = -mhat;
#pragma unroll
      for (int r = 0; r < 16; ++r) { pA0[r] = EX(pA0[r]); pA1[r] = EX(pA1[r]); } }
    WAIT_BAR(0);
    DMA_K(3, 0); DMA_V(1, SLOTB); ROT();
    _Pragma("unroll") for (int d0 = 0; d0 < 4; ++d0) kload2(kf, kp0 + sl_cur, d0);
    LDBIAS(pB0, pB1, 1);
    WAIT_BAR(2);
#define PKW(P, i) cvtpk(P[i], P[i + 1])
#define PAF(k) __builtin_bit_cast(bf16x8, pw##k)
#define VFR(i) (bf16x8){vlo[i][0], vlo[i][1], vlo[i][2], vlo[i][3], vhi[i][0], vhi[i][1], vhi[i][2], vhi[i][3]}
#define VRD(i) do { vlo[i] = vtr(vp_ + (((i) >> 2) * 4096 + ((i) & 3) * 1024)); vhi[i] = vtr(vp_ + (((i) >> 2) * 4096 + ((i) & 3) * 1024 + 512)); } while (0)
#define KRD(G, d0) do { if (G) { kload2(kf, kp0 + sl_next, d0); SBAR(); } } while (0)
#define GAPA(MF, a0, a1, a2, a3, W0, W1, PW) do { MF; sacc += a0; sacc += a1; sacc += a2; sacc += a3; W0; W1; PIN(PW); PIN(sacc); SBAR(); } while (0)
#define GAPB(MF, X, i) do { MF; X[i] = EX(X[i]); X[i + 1] = EX(X[i + 1]); X[i + 2] = EX(X[i + 2]); X[i + 3] = EX(X[i + 3]); PIN(X); SBAR(); } while (0)
#define STEP(C0, C1, P0, P1, t, MASK, GK, GV, GL) do { SBAR(); \
    const lds_cptr vp_ = vp0 + sl_prev; \
    VRD(0); SBAR(); float sacc = P0[0] + P0[1];                                                                                                       \
                    GAPA(C0 = MFMA(kf[0], qr[0], C0), P0[2], P0[3], P0[4], P0[5],     pw0[0] = PKW(P0, 0),  pw0[1] = PKW(P0, 2),  pw0); \
    VRD(4); SBAR(); GAPA(C1 = MFMA(kf[1], qr[0], C1), P0[6], P0[7], P0[8], P0[9],     pw0[2] = PKW(P0, 4),  pw0[3] = PKW(P0, 6),  pw0); \
    VRD(1); SBAR(); GAPA(C0 = MFMA(kf[2], qr[1], C0),    P0[10], P0[11], P0[12], P0[13], pw1[0] = PKW(P0, 8),  pw1[1] = PKW(P0, 10), pw1); \
    VRD(5); SBAR(); GAPA(C1 = MFMA(kf[3], qr[1], C1),    P0[14], P0[15], P1[0], P1[1],   pw1[2] = PKW(P0, 12), pw1[3] = PKW(P0, 14), pw1); \
    VRD(2); SBAR(); GAPA(C0 = MFMA(kf[4], qr[2], C0),    P1[2], P1[3], P1[4], P1[5],     pw2[0] = PKW(P1, 0),  pw2[1] = PKW(P1, 2),  pw2); \
    VRD(6); SBAR(); GAPA(C1 = MFMA(kf[5], qr[2], C1),    P1[6], P1[7], P1[8], P1[9],     pw2[2] = PKW(P1, 4),  pw2[3] = PKW(P1, 6),  pw2); \
    VRD(3); SBAR(); GAPA(C0 = MFMA(kf[6], qr[3], C0),    P1[10], P1[11], P1[12], P1[13], pw3[0] = PKW(P1, 8),  pw3[1] = PKW(P1, 10), pw3); \
    VRD(7); SBAR(); GAPA(C1 = MFMA(kf[7], qr[3], C1),    P1[14], P1[15], 0.f, 0.f,       pw3[2] = PKW(P1, 12), pw3[3] = PKW(P1, 14), pw3); \
    l_reg += sacc; \
    if (GK) DMA_K((t) + 3, sl_cur); if (GV) DMA_V((t) + 1, sl_next);                                                       \
    if (MASK) cmask(C0, C1, (t) - (NT - 4), qrel, hi); \
    { const float rm = __builtin_fmaf(rowmax(C0, C1), C2, -mhat); resc = false;                                            \
      if (__builtin_expect(__any(rm > 8.0f), 0)) { const float dl = __builtin_fmaxf(rm, 0.f); mhat += dl;     \
          const float f = __builtin_amdgcn_exp2f(-dl); l_reg *= f; if (hi == 0) wsf[r32] = f; resc = true; } } \
    const float nmh = -mhat; SBAR(); \
    LDBIAS2(GL, P0, P1, (t) + 1, 0); GAPB(o[0] = MFMA(PAF(0), VFR(0), o[0]), C0, 0);   LDBIAS2(GL, P0, P1, (t) + 1, 1); GAPB(o[1] = MFMA(PAF(0), VFR(4), o[1]), C0, 4); \
    KRD(GL, 0); GAPB(o[0] = MFMA(PAF(1), VFR(1), o[0]), C0, 8);  KRD(GL, 1); GAPB(o[1] = MFMA(PAF(1), VFR(5), o[1]), C0, 12);                                     \
    KRD(GL, 2); GAPB(o[0] = MFMA(PAF(2), VFR(2), o[0]), C1, 0);  KRD(GL, 3); GAPB(o[1] = MFMA(PAF(2), VFR(6), o[1]), C1, 4); \
    LDBIAS2(GL, P0, P1, (t) + 1, 2); GAPB(o[0] = MFMA(PAF(3), VFR(3), o[0]), C1, 8);   LDBIAS2(GL, P0, P1, (t) + 1, 3); GAPB(o[1] = MFMA(PAF(3), VFR(7), o[1]), C1, 12); \
    } while (0)
    int t = 1;
    for (; t + 5 < NT; t += 2) {
        STEP(pB0, pB1, pA0, pA1, t, false, true, true, true);     WAIT_BAR(2); RESC(); ROT();
        STEP(pA0, pA1, pB0, pB1, t + 1, false, true, true, true); WAIT_BAR(2); RESC(); ROT();
    }
#define ENDW(tt) do { if ((tt) + 3 < NT) { WAIT_BAR(2); } else if ((tt) + 2 < NT) { WAIT_BAR(1); } else { WAIT_BAR(0); } } while (0)
    for (; t + 1 < NT; t += 2) {
        STEP(pB0, pB1, pA0, pA1, t, true, (t + 3 < NT), (t + 1 < NT), (t + 1 < NT));         ENDW(t);     RESC(); ROT();
        STEP(pA0, pA1, pB0, pB1, t + 1, true, (t + 4 < NT), (t + 2 < NT), (t + 2 < NT));     ENDW(t + 1); RESC(); ROT();
    }
    STEP(pB0, pB1, pA0, pA1, NT - 1, true, false, false, false); RESC();
    { float sacc = pB0[0] + pB0[1];
#pragma unroll
      for (int r = 2; r < 16; ++r) sacc += pB0[r];
#pragma unroll
      for (int r = 0; r < 16; ++r) sacc += pB1[r];
      l_reg += sacc;
      pw0 = (u32x4){PKW(pB0, 0), PKW(pB0, 2), PKW(pB0, 4), PKW(pB0, 6)}; pw1 = (u32x4){PKW(pB0, 8), PKW(pB0, 10), PKW(pB0, 12), PKW(pB0, 14)};
      pw2 = (u32x4){PKW(pB1, 0), PKW(pB1, 2), PKW(pB1, 4), PKW(pB1, 6)}; pw3 = (u32x4){PKW(pB1, 8), PKW(pB1, 10), PKW(pB1, 12), PKW(pB1, 14)};
      const lds_cptr vp_ = vp0 + sl_cur; _Pragma("unroll") for (int i = 0; i < 8; ++i) VRD(i);
      o[0] = MFMA(PAF(0), VFR(0), o[0]); o[1] = MFMA(PAF(0), VFR(4), o[1]); o[0] = MFMA(PAF(1), VFR(1), o[0]); o[1] = MFMA(PAF(1), VFR(5), o[1]);
      o[0] = MFMA(PAF(2), VFR(2), o[0]); o[1] = MFMA(PAF(2), VFR(6), o[1]); o[0] = MFMA(PAF(3), VFR(3), o[0]); o[1] = MFMA(PAF(3), VFR(7), o[1]); }
    { auto rr = __builtin_amdgcn_permlane32_swap(__float_as_uint(l_reg), __float_as_uint(l_reg), false, false); l_reg = __uint_as_float(rr[0]) + __uint_as_float(rr[1]); }
    if (hi == 0) wsf[32 + r32] = l_reg; asm volatile("s_waitcnt lgkmcnt(0)" ::: "memory");
    float rli[16];
#pragma unroll
    for (int r = 0; r < 16; ++r) rli[r] = __builtin_amdgcn_rcpf(wsf[32 + crow(r, hi)]);
    bf16* Ow = O + (rowbase + q0 + wid * QBLK) * DM + h * D; bf16* stg = (bf16*)(lds + LDS_OST) + wid * 2048;
#pragma unroll
    for (int r = 0; r < 16; ++r) { const int orow = crow(r, hi);
#pragma unroll
        for (int d0 = 0; d0 < 2; ++d0) stg[orow * 64 + d0 * 32 + r32] = __float2bfloat16(o[d0][r] * rli[r]); }
    asm volatile("s_waitcnt lgkmcnt(0)" ::: "memory");
#pragma unroll
    for (int i = 0; i < 4; ++i) { const int row = i * 8 + (lane >> 3), ch = lane & 7; *(u32x4*)(Ow + (long)row * DM + ch * 8) = *(const u32x4*)(stg + row * 64 + ch * 8); }
    asm volatile("s_waitcnt lgkmcnt(0)\n\ts_barrier" ::: "memory");
#undef DMA_K
#undef DMA_V
#undef ROT
#undef EX
#undef RESC
#undef PKW
#undef PAF
#undef VFR
#undef VRD
#undef KRD
#undef ENDW
#undef GAPA
#undef GAPB
#undef STEP
#undef LDBIAS
#undef LDBIAS2
}

#undef SBAR
#undef PIN
#undef MFMA
#undef WAIT_BAR
#undef MX3
}
constexpr int NWAVES = 8;
#ifndef MK_N_LAUNCHES
#define MK_N_LAUNCHES 1
#endif
constexpr int N_PHASES = 11;
constexpr int Bn = 16, Sn = 2048, Dm = 1024, T = Bn * Sn;
constexpr int NPROJ = 6656;
constexpr float ALPHA = 1.189207115002721f;
constexpr float LN_EPS = 1e-5f;
constexpr float GLA_EPS2 = 1e-5f * 128.0f;

constexpr size_t MiB = 1u << 20;
constexpr size_t WS_CTL = 0, CTL_ZERO_BYTES = 1 * MiB;
constexpr size_t WS_WIN = 1 * MiB;
constexpr size_t WS_WOF = 14 * MiB;
constexpr size_t WS_WOG = 15 * MiB;
constexpr size_t WS_WO  = 17 * MiB;
constexpr size_t WS_WQ  = 19 * MiB;
constexpr size_t WS_SK  = 23 * MiB;
constexpr size_t WS_EU  = 24 * MiB;
constexpr size_t WS_EV  = 40 * MiB;
constexpr size_t WS_SU  = 56 * MiB;
constexpr size_t WS_SV  = 56 * MiB + 65536;
constexpr size_t WS_FF  = 88 * MiB;
constexpr size_t WS_GLR = 89 * MiB;
constexpr size_t WS_CB  = 91 * MiB;
constexpr size_t WS_XB  = 92 * MiB;
constexpr size_t WS_FQ  = 156 * MiB;
constexpr size_t WS_FK  = 188 * MiB, WS_FV = 220 * MiB, WS_GQ = 252 * MiB, WS_GK = 284 * MiB;
constexpr size_t WS_GV  = 316 * MiB;
constexpr size_t WS_GG  = 380 * MiB;
constexpr size_t WS_IDX = 444 * MiB;
constexpr size_t WS_GATE = 452 * MiB;
constexpr size_t WS_END = 468 * MiB;
constexpr size_t WS_Y = WS_FQ, WS_QP = WS_GV;
constexpr int CW_TMO = 0, CW_BAR = 4096;

constexpr int RING_BYTES = 131072;
constexpr int LDSCTL_OFF = 160 * 1024 - 512, MISC_OFF = LDSCTL_OFF + 320;
constexpr int LDS_BYTES = 160 * 1024;

typedef unsigned long long u64;
typedef unsigned v2u __attribute__((ext_vector_type(2)));
typedef float f32x16 __attribute__((ext_vector_type(16)));
typedef short s16x4v __attribute__((ext_vector_type(4)));
typedef __bf16 bf16x2_t __attribute__((ext_vector_type(2)));

__device__ __forceinline__ float bf_lo(unsigned u) { return __builtin_bit_cast(float, u << 16); }
__device__ __forceinline__ float bf_hi(unsigned u) { return __builtin_bit_cast(float, u & 0xffff0000u); }
__device__ __forceinline__ float sigmoidf_(float x) { return __builtin_amdgcn_rcpf(1.0f + __expf(-x)); }
__device__ __forceinline__ float wave_sum(float v) {
#pragma unroll
    for (int o = 1; o < 64; o <<= 1) v += __shfl_xor(v, o);
    return v;
}
__device__ __forceinline__ float dot2bf(unsigned a, unsigned b, float c) { asm("v_dot2c_f32_bf16 %0, %1, %2" : "+v"(c) : "v"(a), "v"(b)); return c; }
__device__ __forceinline__ float gelu_erf(float v) { return 0.5f * v * (1.0f + erff(v * 0.70710678118654752f)); }

namespace pg8 {
struct EpiProj {
    static constexpr bool PERM = true, AFTER_DRAIN = false;
    unsigned char* ws; unsigned char* dout;
    __device__ __forceinline__ void operator()(const f32x4 (&acc)[2][2][4][2], const Unit& u, int wr, int wc, int fr, int fq) const {
        const int pn = u.pn; bf16_t* base; int ldc, colt;
        if (pn < 10)      { base = (bf16_t*)(ws + WS_FQ + (size_t)(pn >> 1) * (32 * MiB)); ldc = 512; colt = (pn & 1) * 256; }
        else if (pn < 18) { base = (bf16_t*)(ws + WS_GV + (size_t)((pn - 10) >> 2) * (64 * MiB)); ldc = 1024; colt = ((pn - 10) & 3) * 256; }
        else              { base = (bf16_t*)(dout + (size_t)((pn - 18) >> 2) * (64 * MiB)); ldc = 1024; colt = ((pn - 18) & 3) * 256; }
        const int row0 = u.pm * BM + wr * 64 + fr, col0 = colt + wc * 32 + 8 * fq;
#pragma unroll
        for (int ai = 0; ai < 2; ++ai)
#pragma unroll
            for (int m = 0; m < 4; ++m) { bf16_t* rowp = base + (size_t)(row0 + ai * HALF + m * 16) * ldc + col0;
#pragma unroll
                for (int bj = 0; bj < 2; ++bj) { const f32x4 v0 = acc[ai][bj][m][0], v1 = acc[ai][bj][m][1];
                    u32x4 w; w.x = cvt_pk_bf16(v0[0], v0[1]); w.y = cvt_pk_bf16(v0[2], v0[3]); w.z = cvt_pk_bf16(v1[0], v1[1]); w.w = cvt_pk_bf16(v1[2], v1[3]);
                    *(u32x4*)(rowp + bj * HALF) = w; } }
    }
};
template <int MODE> struct EpiGate {
    static constexpr bool PERM = true, AFTER_DRAIN = false;
    const bf16_t* G; bf16_t* O;
    __device__ __forceinline__ void operator()(const f32x4 (&acc)[2][2][4][2], const Unit& u, int wr, int wc, int fr, int fq) const {
        const int row0 = u.pm * BM + wr * 64 + fr, col0 = u.pn * BM + wc * 32 + 8 * fq;
#pragma unroll
        for (int ai = 0; ai < 2; ++ai)
#pragma unroll
            for (int m = 0; m < 4; ++m) { const size_t off = (size_t)(row0 + ai * HALF + m * 16) * 1024 + col0;
#pragma unroll
                for (int bj = 0; bj < 2; ++bj) { const f32x4 v0 = acc[ai][bj][m][0], v1 = acc[ai][bj][m][1];
                    const u32x4 g = *(const u32x4*)(G + off + bj * HALF);
                    float r[8];
                    r[0] = v0[0] * sigmoidf_(bf_lo(g.x)); r[1] = v0[1] * sigmoidf_(bf_hi(g.x)); r[2] = v0[2] * sigmoidf_(bf_lo(g.y)); r[3] = v0[3] * sigmoidf_(bf_hi(g.y));
                    r[4] = v1[0] * sigmoidf_(bf_lo(g.z)); r[5] = v1[1] * sigmoidf_(bf_hi(g.z)); r[6] = v1[2] * sigmoidf_(bf_lo(g.w)); r[7] = v1[3] * sigmoidf_(bf_hi(g.w));
                    if (MODE == 1) { const u32x4 o = *(const u32x4*)(O + off + bj * HALF);
                        r[0] += bf_lo(o.x); r[1] += bf_hi(o.x); r[2] += bf_lo(o.y); r[3] += bf_hi(o.y); r[4] += bf_lo(o.z); r[5] += bf_hi(o.z); r[6] += bf_lo(o.w); r[7] += bf_hi(o.w); }
                    u32x4 w; w.x = cvt_pk_bf16(r[0], r[1]); w.y = cvt_pk_bf16(r[2], r[3]); w.z = cvt_pk_bf16(r[4], r[5]); w.w = cvt_pk_bf16(r[6], r[7]);
                    *(u32x4*)(O + off + bj * HALF) = w; } }
    }
};
struct EpiMix {
    static constexpr bool PERM = false, AFTER_DRAIN = false;
    const float* X; float* Y;
    __device__ __forceinline__ void operator()(const f32x4 (&acc)[2][2][4][2], const Unit& u, int wr, int wc, int fr, int fq) const {
        const int row0 = u.pm * BM + wr * 64 + fr, col0 = u.pn * BM + wc * 32 + 4 * fq;
#pragma unroll
        for (int ai = 0; ai < 2; ++ai)
#pragma unroll
            for (int m = 0; m < 4; ++m) { const size_t off = (size_t)(row0 + ai * HALF + m * 16) * 1024 + col0;
#pragma unroll
                for (int bj = 0; bj < 2; ++bj)
#pragma unroll
                    for (int n = 0; n < 2; ++n) { const f32x4 xv = *(const f32x4*)(X + off + bj * HALF + n * 16); *(f32x4*)(Y + off + bj * HALF + n * 16) = xv * ALPHA + acc[ai][bj][m][n]; } }
    }
};
}

struct Frame {
    LAS unsigned char* lds;
    volatile LAS unsigned* MISC;
    gu32* ctl;
    int tid, lane, wave, vcu, G;
};

__device__ __forceinline__ void transpose_item(const float* W, int ldw, int src_col0, bf16* WT, int K, int dst_row0, LAS float* scr, int k0, int lane) {
#pragma unroll 8
    for (int i = 0; i < 32; ++i) { const int kk = 2 * i + (lane >> 5); scr[kk * 33 + (lane & 31)] = W[(size_t)(k0 + kk) * ldw + src_col0 + (lane & 31)]; }
    LDS_WAIT(); asm volatile("" ::: "memory");
    const int c = lane & 7;
#pragma unroll
    for (int j = 0; j < 4; ++j) { const int n = (lane >> 3) + 8 * j; const LAS float* s = scr + (8 * c) * 33 + n;
        v4u o; o.x = pk2(s[0 * 33], s[1 * 33]); o.y = pk2(s[2 * 33], s[3 * 33]); o.z = pk2(s[4 * 33], s[5 * 33]); o.w = pk2(s[6 * 33], s[7 * 33]);
        *(GAS v4u*)(WT + (size_t)(dst_row0 + n) * K + k0 + 8 * c) = o; }
    LDS_WAIT(); asm volatile("" ::: "memory");
}
__device__ __forceinline__ void convert_flat(Frame& F, const float* src, bf16* dst, size_t n8) {
    const size_t gt = (size_t)F.vcu * 512 + F.tid, NT_ = (size_t)F.G * 512;
    for (size_t i = gt; i < n8; i += NT_) { const f32x4 a = *(const GAS f32x4*)(src + i * 8), b = *(const GAS f32x4*)(src + i * 8 + 4);
        v4u o; o.x = pk2(a.x, a.y); o.y = pk2(a.z, a.w); o.z = pk2(b.x, b.y); o.w = pk2(b.z, b.w); *(GAS v4u*)(dst + i * 8) = o; }
}

struct In {
    const float *x, *w_in, *fox_f_bias, *gla_gate_up, *gla_gate_bias, *gla_norm_gain, *w_out_fox, *w_out_gla, *w_out, *ln1_gain, *ln1_bias,
                *peer_w_query, *peer_sub_keys, *peer_expert_u, *peer_expert_v, *ln2_gain, *ln2_bias;
};

__device__ __forceinline__ void p0_prologue(Frame& F, const In& I, unsigned char* ws) {
    const int gw = F.vcu * NWAVES + F.wave, NGW = F.G * NWAVES;
    {
        LAS float* scr = (LAS float*)(F.lds + F.wave * 16384);
        constexpr int I_IN = 16 * 208, I_OF = 8 * 32, I_OG = 16 * 32, I_O = 16 * 32, I_Q = 16 * 64;
        constexpr int NITEMS = I_IN + I_OF + I_OG + I_O + I_Q;
        for (int it = gw; it < NITEMS; it += NGW) {
            int r = it;
            if (r < I_IN) { const int kb = r / 208, nb = r % 208; const int sc = 32 * nb + (nb >= 48 ? 8 : 0) + (nb >= 144 ? 16 : 0);
                transpose_item(I.w_in, 6680, sc, (bf16*)(ws + WS_WIN), 1024, 32 * nb, scr, 64 * kb, F.lane); continue; } r -= I_IN;
            if (r < I_OF) { const int kb = r / 32, nb = r % 32; transpose_item(I.w_out_fox, 1024, 32 * nb, (bf16*)(ws + WS_WOF), 512, 32 * nb, scr, 64 * kb, F.lane); continue; } r -= I_OF;
            if (r < I_OG) { const int kb = r / 32, nb = r % 32; transpose_item(I.w_out_gla, 1024, 32 * nb, (bf16*)(ws + WS_WOG), 1024, 32 * nb, scr, 64 * kb, F.lane); continue; } r -= I_OG;
            if (r < I_O)  { const int kb = r / 32, nb = r % 32; transpose_item(I.w_out, 1024, 32 * nb, (bf16*)(ws + WS_WO), 1024, 32 * nb, scr, 64 * kb, F.lane); continue; } r -= I_O;
            { const int kb = r / 64, nb = r % 64; transpose_item(I.peer_w_query, 2048, 32 * nb, (bf16*)(ws + WS_WQ), 1024, 32 * nb, scr, 64 * kb, F.lane); }
        }
    }
    convert_flat(F, I.peer_sub_keys, (bf16*)(ws + WS_SK), (size_t)8 * 2 * 128 * 128 / 8);
    for (int r = gw; r < 2 * 16384; r += NGW) {
        const int tab = r >> 14, row = r & 16383; const float* src = (tab ? I.peer_expert_v : I.peer_expert_u) + (size_t)row * Dm;
        const GAS f32x4* xr = (const GAS f32x4*)src + F.lane; f32x4 v[4]; float am = 0.f;
#pragma unroll
        for (int j = 0; j < 4; ++j) { v[j] = xr[64 * j]; am = fmaxf(am, fmaxf(fmaxf(fabsf(v[j].x), fabsf(v[j].y)), fmaxf(fabsf(v[j].z), fabsf(v[j].w)))); }
#pragma unroll
        for (int o = 1; o < 64; o <<= 1) am = fmaxf(am, __shfl_xor(am, o));
        const float sc = am > 0.f ? 240.0f / am : 1.0f, inv = am > 0.f ? am * (1.0f / 240.0f) : 1.0f;
        GAS unsigned* dst = (GAS unsigned*)(ws + (tab ? WS_EV : WS_EU) + (size_t)row * 1024) + F.lane;
#pragma unroll
        for (int j = 0; j < 4; ++j) { int q = __builtin_amdgcn_cvt_pk_fp8_f32(v[j].x * sc, v[j].y * sc, 0, false); q = __builtin_amdgcn_cvt_pk_fp8_f32(v[j].z * sc, v[j].w * sc, q, true); dst[64 * j] = (unsigned)q; }
        if (F.lane == 0) ((float*)(ws + (tab ? WS_SV : WS_SU)))[row] = inv;
    }
    __syncthreads();
    {
        LAS float* WSl = (LAS float*)F.lds;
        for (int idx = F.tid; idx < 24 * 1024; idx += 512) { const int k = idx / 24, j = idx % 24; const int col = j < 8 ? 1536 + j : 4616 + (j - 8);
            WSl[j * 1028 + k] = I.w_in[(size_t)k * 6680 + col]; }
        __syncthreads();
        float* FFo = (float*)(ws + WS_FF); float* GLRo = (float*)(ws + WS_GLR); bf16* XB = (bf16*)(ws + WS_XB);
        for (int m = gw; m < T; m += NGW) {
            const GAS f32x4* xr = (const GAS f32x4*)(I.x + (size_t)m * Dm) + F.lane;
            f32x4 v[4];
#pragma unroll
            for (int j = 0; j < 4; ++j) v[j] = xr[64 * j];
            GAS u64* o8 = (GAS u64*)(XB + (size_t)m * Dm) + F.lane;
#pragma unroll
            for (int j = 0; j < 4; ++j) o8[64 * j] = (u64)pk2(v[j].x, v[j].y) | ((u64)pk2(v[j].z, v[j].w) << 32);
            float mine = 0.f;
#pragma unroll 1
            for (int jo = 0; jo < 24; ++jo) { float s = 0.f;
#pragma unroll
                for (int j = 0; j < 4; ++j) { const f32x4 w = *(const LAS f32x4*)(WSl + jo * 1028 + 4 * F.lane + 256 * j); s += (v[j].x * w.x + v[j].y * w.y) + (v[j].z * w.z + v[j].w * w.w); }
                s = wave_sum(s); if (F.lane == jo) mine = s; }
            if (F.lane < 8) FFo[(size_t)m * 8 + F.lane] = mine; else if (F.lane < 24) GLRo[(size_t)m * 16 + (F.lane - 8)] = mine;
        }
    }
}

__device__ __forceinline__ void p1_forget_cumsum(Frame& F, const In& I, unsigned char* ws) {
    if (F.vcu >= 128) return;
    const int b = F.vcu >> 3, h = F.vcu & 7; const float fb = I.fox_f_bias[h];
    const float* FFi = (const float*)(ws + WS_FF); float* CB = (float*)(ws + WS_CB) + (size_t)F.vcu * Sn;
    LAS float* wt = (LAS float*)F.lds;
    float ls[4]; float run = 0.f;
#pragma unroll
    for (int j = 0; j < 4; ++j) { const float f = FFi[((size_t)b * Sn + 4 * F.tid + j) * 8 + h] + fb; const float l = fminf(f, 0.f) - __logf(1.0f + __expf(-fabsf(f))); run += l; ls[j] = run; }
    float inc = run;
#pragma unroll
    for (int o = 1; o < 64; o <<= 1) { const float t = __shfl_up(inc, o); if (F.lane >= o) inc += t; }
    if (F.lane == 63) wt[F.wave] = inc;
    __syncthreads();
    float woff = 0.f;
#pragma unroll
    for (int w = 0; w < 8; ++w) if (w < F.wave) woff += wt[w];
    const float off = woff + inc - run;
    f32x4 o; o.x = -8.f * (off + ls[0]); o.y = -8.f * (off + ls[1]); o.z = -8.f * (off + ls[2]); o.w = -8.f * (off + ls[3]);
    *(GAS f32x4*)(CB + 4 * F.tid) = o;
    __syncthreads();
}

namespace gla {
typedef __attribute__((address_space(3))) unsigned char* lptr;
typedef __attribute__((address_space(3))) const unsigned char* lcptr;
typedef short v4i16_t __attribute__((ext_vector_type(4)));
constexpr int KD_STRIDE = 320, V_STRIDE = 576, Q_STRIDE = 264, G_STRIDE = 520;
constexpr int L_KD = 0, L_V = 20480, L_Q = 57344, L_G = 74240, L_GLR = 107520, L_CT = 111616, L_DT = 113664, L_RS = 114176, L_GN = 116224, GLA_LDS = 117248;
__device__ __forceinline__ s16x4v tr4(lcptr p) { return __builtin_bit_cast(s16x4v, __builtin_amdgcn_ds_read_tr16_b64_v4i16((__attribute__((address_space(3))) v4i16_t*)p)); }
__device__ __forceinline__ int crow(int r, int hi) { return (r & 3) + 8 * (r >> 2) + 4 * hi; }
typedef float f32x2_t __attribute__((ext_vector_type(2)));
__device__ __forceinline__ unsigned cvtpk(float lo, float hi) { const f32x2_t v = {lo, hi}; const bf16x2_t bb = __builtin_convertvector(v, bf16x2_t); return __builtin_bit_cast(unsigned, bb); }

struct Pre { v4u k[2], q[2], v[4], g[4]; v2u glr; };

__device__ __forceinline__ void load_chunk(Pre& P, int tid, size_t row0, int h, const bf16* GQ, const bf16* GK, const bf16* GV, const bf16* GG, const float* GLRi) {
#pragma unroll
    for (int j = 0; j < 2; ++j) { const int p = tid + 512 * j, row = p >> 4, c = p & 15;
        P.k[j] = *(const GAS v4u*)(GK + (row0 + row) * 512 + h * 128 + c * 8); P.q[j] = *(const GAS v4u*)(GQ + (row0 + row) * 512 + h * 128 + c * 8); }
#pragma unroll
    for (int j = 0; j < 4; ++j) { const int p = tid + 512 * j, row = p >> 5, c = p & 31;
        P.v[j] = *(const GAS v4u*)(GV + (row0 + row) * 1024 + h * 256 + c * 8); P.g[j] = *(const GAS v4u*)(GG + (row0 + row) * 1024 + h * 256 + c * 8); }
    P.glr = *(const GAS v2u*)(GLRi + row0 * 16 + tid * 2);
}
__device__ __forceinline__ void store_chunk(const Pre& P, int tid, lptr lds) {
#pragma unroll
    for (int j = 0; j < 2; ++j) { const int p = tid + 512 * j, row = p >> 4, c = p & 15;
        *(__attribute__((address_space(3))) v4u*)(lds + L_KD + row * KD_STRIDE + c * 16) = P.k[j];
        __attribute__((address_space(3))) v2u* qd = (__attribute__((address_space(3))) v2u*)(lds + L_Q + row * Q_STRIDE + c * 16);
        qd[0] = (v2u){P.q[j].x, P.q[j].y}; qd[1] = (v2u){P.q[j].z, P.q[j].w}; }
#pragma unroll
    for (int j = 0; j < 4; ++j) { const int p = tid + 512 * j, row = p >> 5, c = p & 31;
        *(__attribute__((address_space(3))) v4u*)(lds + L_V + row * V_STRIDE + c * 16) = P.v[j];
        __attribute__((address_space(3))) v2u* gd = (__attribute__((address_space(3))) v2u*)(lds + L_G + row * G_STRIDE + c * 16);
        gd[0] = (v2u){P.g[j].x, P.g[j].y}; gd[1] = (v2u){P.g[j].z, P.g[j].w}; }
    *(__attribute__((address_space(3))) v2u*)(lds + L_GLR + tid * 8) = P.glr;
}

__device__ __forceinline__ void gla_unit(int b, int h, const bf16* GQ, const bf16* GK, const bf16* GV, const bf16* GG, const float* GLRi,
                                         const float* up, const float* gbias, const float* gain, bf16* OG, lptr lds, unsigned long long& tacc) {
    const int tid = threadIdx.x, lane = tid & 63, r32 = lane & 31, hi = lane >> 5; const int wid = __builtin_amdgcn_readfirstlane(tid >> 6);
    const int d = tid & 127, qt = tid >> 7;
    float upr[16];
#pragma unroll
    for (int r = 0; r < 16; ++r) upr[r] = up[r * 512 + h * 128 + d];
    const float bz = gbias[h * 128 + d];
    f32x16 S[4];
#pragma unroll
    for (int rb = 0; rb < 4; ++rb) S[rb] = f32x16{};
    const size_t rowb = (size_t)b * Sn;
    if (tid < 256) ((__attribute__((address_space(3))) float*)(lds + L_GN))[tid] = gain[h * 256 + tid];
    Pre P;
    load_chunk(P, tid, rowb, h, GQ, GK, GV, GG, GLRi);
    store_chunk(P, tid, lds);
    __syncthreads();
    const int G4 = lane >> 4, q4 = (lane & 15) >> 2, p4 = lane & 3, cb16 = G4 & 1;
    const lcptr a_base = (lcptr)lds + L_KD + (8 * hi + q4) * KD_STRIDE + (16 * cb16 + 4 * p4) * 2;
    const lcptr b_base = (lcptr)lds + L_V + (8 * hi + q4) * V_STRIDE + (32 * wid + 16 * cb16 + 4 * p4) * 2;
#if defined(MK_GLA_T)
#define GT(k) do { __builtin_amdgcn_sched_barrier(0); unsigned long long t_; asm volatile("s_memrealtime %0\n\ts_waitcnt lgkmcnt(0)" : "=s"(t_) :: "memory"); if ((k) == MK_GLA_T) tacc -= t_; if ((k) == MK_GLA_T + MK_GLA_N) tacc += t_; __builtin_amdgcn_sched_barrier(0); } while (0)
#else
#define GT(k) do { } while (0)
#endif
    for (int c = 0; c < 32; ++c) {
        GT(1);
        if (c + 1 < 32) load_chunk(P, tid, rowb + (size_t)(c + 1) * 64, h, GQ, GK, GV, GG, GLRi);
        GT(2);
        {
            float cumv[16];
#pragma unroll
            for (int ii = 0; ii < 16; ++ii) cumv[ii] = bz;
#pragma unroll
            for (int rq = 0; rq < 4; ++rq)
#pragma unroll
                for (int ii = 0; ii < 16; ++ii) { const f32x4 g0 = *(const __attribute__((address_space(3))) f32x4*)(lds + L_GLR + (16 * qt + ii) * 64 + rq * 16);
                    cumv[ii] += (g0.x * upr[4 * rq] + g0.y * upr[4 * rq + 1]) + (g0.z * upr[4 * rq + 2] + g0.w * upr[4 * rq + 3]); }
#pragma unroll
            for (int ii = 0; ii < 16; ++ii) { const float z = cumv[ii]; cumv[ii] = (fminf(z, 0.f) - __logf(1.0f + __expf(-fabsf(z)))) * (1.0f / 16.0f); }
            float run = 0.f;
#pragma unroll
            for (int ii = 0; ii < 16; ++ii) { run += cumv[ii]; cumv[ii] = run; }
            __attribute__((address_space(3))) float* CT = (__attribute__((address_space(3))) float*)(lds + L_CT);
            CT[qt * 128 + d] = run;
            __syncthreads();
            const float t0 = CT[d], t1 = CT[128 + d], t2 = CT[256 + d], t3 = CT[384 + d];
            const float total = (t0 + t1) + (t2 + t3);
            const float off = (qt > 0 ? t0 : 0.f) + (qt > 1 ? t1 : 0.f) + (qt > 2 ? t2 : 0.f);
            unsigned short kraw[16];
#pragma unroll
            for (int ii = 0; ii < 16; ++ii) kraw[ii] = *(const __attribute__((address_space(3))) unsigned short*)(lds + L_KD + (16 * qt + ii) * KD_STRIDE + d * 2);
#pragma unroll
            for (int ii = 0; ii < 16; ++ii) { const float kf = __builtin_bit_cast(float, (unsigned)kraw[ii] << 16) * __expf(total - (off + cumv[ii])); kraw[ii] = (unsigned short)f2bf(kf); }
#pragma unroll
            for (int ii = 0; ii < 16; ++ii) *(__attribute__((address_space(3))) unsigned short*)(lds + L_KD + (16 * qt + ii) * KD_STRIDE + d * 2) = kraw[ii];
            if (qt == 0) ((__attribute__((address_space(3))) float*)(lds + L_DT))[d] = __expf(total);
            __syncthreads();
        }
        GT(3);
        {
#pragma unroll
            for (int rb = 0; rb < 4; ++rb)
#pragma unroll
                for (int g = 0; g < 4; ++g) { const f32x4 dt = *(const __attribute__((address_space(3))) f32x4*)(lds + L_DT + (32 * rb + 8 * g + 4 * hi) * 4);
                    S[rb][4 * g] *= dt.x; S[rb][4 * g + 1] *= dt.y; S[rb][4 * g + 2] *= dt.z; S[rb][4 * g + 3] *= dt.w; }
#pragma unroll
            for (int s = 0; s < 4; ++s) {
                const s16x4v b0 = tr4(b_base + s * 16 * V_STRIDE), b1 = tr4(b_base + s * 16 * V_STRIDE + 4 * V_STRIDE);
                const bf16x8 bf = (bf16x8){b0[0], b0[1], b0[2], b0[3], b1[0], b1[1], b1[2], b1[3]};
#pragma unroll
                for (int rb = 0; rb < 4; ++rb) {
                    const s16x4v a0 = tr4(a_base + s * 16 * KD_STRIDE + rb * 64), a1 = tr4(a_base + s * 16 * KD_STRIDE + 4 * KD_STRIDE + rb * 64);
                    const bf16x8 af = (bf16x8){a0[0], a0[1], a0[2], a0[3], a1[0], a1[1], a1[2], a1[3]};
                    S[rb] = __builtin_amdgcn_mfma_f32_32x32x16_bf16(af, bf, S[rb], 0, 0, 0);
                }
            }
        }
        GT(4);
        f32x16 ob[2]; ob[0] = f32x16{}; ob[1] = f32x16{};
        {
#pragma unroll
            for (int rb = 0; rb < 4; ++rb)
#pragma unroll
                for (int s2 = 0; s2 < 2; ++s2) {
                    v4u sp; sp.x = cvtpk(S[rb][8 * s2 + 0], S[rb][8 * s2 + 1]); sp.y = cvtpk(S[rb][8 * s2 + 2], S[rb][8 * s2 + 3]);
                    sp.z = cvtpk(S[rb][8 * s2 + 4], S[rb][8 * s2 + 5]); sp.w = cvtpk(S[rb][8 * s2 + 6], S[rb][8 * s2 + 7]);
                    const bf16x8 sf = __builtin_bit_cast(bf16x8, sp);
#pragma unroll
                    for (int ib = 0; ib < 2; ++ib) {
                        const lcptr qrow = (lcptr)lds + L_Q + (32 * ib + r32) * Q_STRIDE + (32 * rb + 16 * s2 + 4 * hi) * 2;
                        const v2u lo = *(const __attribute__((address_space(3))) v2u*)(qrow), hi2 = *(const __attribute__((address_space(3))) v2u*)(qrow + 16);
                        const bf16x8 qf = __builtin_bit_cast(bf16x8, (v4u){lo.x, lo.y, hi2.x, hi2.y});
                        ob[ib] = __builtin_amdgcn_mfma_f32_32x32x16_bf16(sf, qf, ob[ib], 0, 0, 0);
                    }
                }
        }
        GT(5);
        {
            __attribute__((address_space(3))) float* RS = (__attribute__((address_space(3))) float*)(lds + L_RS);
#pragma unroll
            for (int ib = 0; ib < 2; ++ib) { float ss = 0.f;
#pragma unroll
                for (int r = 0; r < 16; ++r) ss += ob[ib][r] * ob[ib][r];
                auto rr = __builtin_amdgcn_permlane32_swap(__float_as_uint(ss), __float_as_uint(ss), false, false); ss = __uint_as_float(rr[0]) + __uint_as_float(rr[1]);
                if (hi == 0) RS[wid * 64 + 32 * ib + r32] = ss; }
            __syncthreads();
            v2u ggv[2][4]; float rstd2[2];
#pragma unroll
            for (int ib = 0; ib < 2; ++ib) { const int i = 32 * ib + r32; float tot = 0.f;
#pragma unroll
                for (int w = 0; w < 8; ++w) tot += RS[w * 64 + i];
                rstd2[ib] = __builtin_amdgcn_rsqf(tot * (1.0f / 256.0f) + GLA_EPS2);
#pragma unroll
                for (int g = 0; g < 4; ++g) ggv[ib][g] = *(const __attribute__((address_space(3))) v2u*)(lds + L_G + i * G_STRIDE + (32 * wid + 8 * g + 4 * hi) * 2); }
            f32x4 gnv[4];
#pragma unroll
            for (int g = 0; g < 4; ++g) gnv[g] = *(const __attribute__((address_space(3))) f32x4*)(lds + L_GN + (32 * wid + 8 * g + 4 * hi) * 4);
#pragma unroll
            for (int ib = 0; ib < 2; ++ib) { const int i = 32 * ib + r32;
#pragma unroll
                for (int g = 0; g < 4; ++g) { const v2u gg = ggv[ib][g]; const f32x4 gn = gnv[g]; const float rstd = rstd2[ib];
                    const float x0 = bf_lo(gg.x), x1 = bf_hi(gg.x), x2 = bf_lo(gg.y), x3 = bf_hi(gg.y);
                    const float o0 = ob[ib][4 * g] * rstd * gn.x * (x0 * sigmoidf_(x0)), o1 = ob[ib][4 * g + 1] * rstd * gn.y * (x1 * sigmoidf_(x1));
                    const float o2 = ob[ib][4 * g + 2] * rstd * gn.z * (x2 * sigmoidf_(x2)), o3 = ob[ib][4 * g + 3] * rstd * gn.w * (x3 * sigmoidf_(x3));
                    ggv[ib][g] = (v2u){cvtpk(o0, o1), cvtpk(o2, o3)}; } }
#pragma unroll
            for (int ib = 0; ib < 2; ++ib)
#pragma unroll
                for (int g = 0; g < 4; ++g) *(__attribute__((address_space(3))) v2u*)(lds + L_G + (32 * ib + r32) * G_STRIDE + (32 * wid + 8 * g + 4 * hi) * 2) = ggv[ib][g];
            __syncthreads();
        }
        GT(6);
        {
#pragma unroll
            for (int j = 0; j < 4; ++j) { const int p = tid + 512 * j, row = p >> 5, cc = p & 31;
                const __attribute__((address_space(3))) v2u* gs = (const __attribute__((address_space(3))) v2u*)(lds + L_G + row * G_STRIDE + cc * 16);
                const v2u a = gs[0], bb = gs[1];
                *(GAS v4u*)(OG + (rowb + (size_t)c * 64 + row) * 1024 + h * 256 + cc * 8) = (v4u){a.x, a.y, bb.x, bb.y}; }
            __syncthreads();
        }
        GT(7);
        if (c + 1 < 32) { store_chunk(P, tid, lds); }
        __syncthreads();
        GT(8);
    }
}
}

__device__ __forceinline__ void p7_ln1(Frame& F, const In& I, unsigned char* ws) {
    const int gw = F.vcu * NWAVES + F.wave, NGW = F.G * NWAVES;
    const float* Y = (const float*)(ws + WS_Y); bf16* X1 = (bf16*)(ws + WS_XB);
    f32x4 gv[4], bv[4];
#pragma unroll
    for (int j = 0; j < 4; ++j) { gv[j] = *((const GAS f32x4*)I.ln1_gain + F.lane + 64 * j); bv[j] = *((const GAS f32x4*)I.ln1_bias + F.lane + 64 * j); }
    for (int m = gw; m < T; m += NGW) {
        const GAS f32x4* yr = (const GAS f32x4*)(Y + (size_t)m * Dm) + F.lane;
        f32x4 v[4]; float s = 0.f;
#pragma unroll
        for (int j = 0; j < 4; ++j) { v[j] = yr[64 * j]; s += (v[j].x + v[j].y) + (v[j].z + v[j].w); }
        const float mean = wave_sum(s) * (1.f / Dm); float s2 = 0.f;
#pragma unroll
        for (int j = 0; j < 4; ++j) { v[j] = v[j] - mean; s2 += (v[j].x * v[j].x + v[j].y * v[j].y) + (v[j].z * v[j].z + v[j].w * v[j].w); }
        const float rstd = 1.f / sqrtf(wave_sum(s2) * (1.f / Dm) + LN_EPS);
        GAS u64* o8 = (GAS u64*)(X1 + (size_t)m * Dm) + F.lane;
#pragma unroll
        for (int j = 0; j < 4; ++j) { const f32x4 o = v[j] * rstd * gv[j] + bv[j]; o8[64 * j] = (u64)pk2(o.x, o.y) | ((u64)pk2(o.z, o.w) << 32); }
    }
}

namespace topk {
template <int LO, int CNT, bool DESC> __device__ __forceinline__ void bmerge(unsigned* k) {
    if constexpr (CNT > 1) { constexpr int H = CNT / 2;
#pragma unroll
        for (int i = 0; i < H; ++i) { const unsigned a = k[LO + i], b = k[LO + i + H]; const unsigned mx = a > b ? a : b, mn = a > b ? b : a; k[LO + i] = DESC ? mx : mn; k[LO + i + H] = DESC ? mn : mx; }
        bmerge<LO, H, DESC>(k); bmerge<LO + H, H, DESC>(k); }
}
template <int LO, int CNT, bool DESC> __device__ __forceinline__ void bsort(unsigned* k) {
    if constexpr (CNT > 1) { bsort<LO, CNT / 2, true>(k); bsort<LO + CNT / 2, CNT / 2, false>(k); bmerge<LO, CNT, DESC>(k); }
}
__device__ __forceinline__ void top16_of_64(unsigned* k) {
    bsort<0, 16, true>(k); bsort<16, 16, false>(k);
#pragma unroll
    for (int i = 0; i < 16; ++i) k[i] = k[i] > k[16 + i] ? k[i] : k[16 + i];
    bmerge<0, 16, true>(k);
    bsort<32, 16, true>(k); bsort<48, 16, false>(k);
#pragma unroll
    for (int i = 0; i < 16; ++i) k[32 + i] = k[32 + i] > k[48 + i] ? k[32 + i] : k[48 + i];
    bmerge<32, 16, false>(k);
#pragma unroll
    for (int i = 0; i < 16; ++i) k[i] = k[i] > k[32 + i] ? k[i] : k[32 + i];
    bmerge<0, 16, true>(k);
}
__device__ __forceinline__ void merge_halves(unsigned* k, int hi) {
    unsigned p[16];
#pragma unroll
    for (int i = 0; i < 16; ++i) { auto rr = __builtin_amdgcn_permlane32_swap(k[i], k[i], false, false); p[i] = hi ? rr[0] : rr[1]; }
#pragma unroll
    for (int i = 0; i < 16; ++i) k[i] = k[i] > p[15 - i] ? k[i] : p[15 - i];
    bmerge<0, 16, true>(k);
}
__device__ __forceinline__ unsigned fmap(float f) { const unsigned u = __float_as_uint(f); const unsigned m = (unsigned)((int)u >> 31); return u ^ (m | 0x80000000u); }
__device__ __forceinline__ float funmap(unsigned k) { const unsigned m = (unsigned)((int)k >> 31); return __uint_as_float(k ^ (~m | 0x80000000u)); }
struct CandTab { unsigned char i[50], j[50]; };
__host__ __device__ constexpr CandTab make_cands() { CandTab t{}; int n = 0; for (int i = 0; i < 16; ++i) for (int j = 0; j < 16; ++j) if ((i + 1) * (j + 1) <= 16) { t.i[n] = (unsigned char)i; t.j[n] = (unsigned char)j; ++n; } return t; }
constexpr CandTab CT_ = make_cands();
constexpr int SK_LDS = 65536, NL_OFF = 65536;

__device__ __forceinline__ void task(int t0, int h, const bf16* QP, unsigned short* IDX, float* GATE, __attribute__((address_space(3))) const unsigned char* SKl,
                                     __attribute__((address_space(3))) unsigned char* NL, int lane) {
    const int r32 = lane & 31, hi = lane >> 5;
    unsigned K0[16], K1[16];
#pragma unroll
    for (int p = 0; p < 2; ++p) {
        bf16x8 qf[8];
#pragma unroll
        for (int ks = 0; ks < 8; ++ks) qf[ks] = *(const GAS bf16x8*)(QP + (size_t)(t0 + r32) * 2048 + h * 256 + p * 128 + 16 * ks + 8 * hi);
        f32x16 acc[4];
#pragma unroll
        for (int nb = 0; nb < 4; ++nb) { acc[nb] = f32x16{};
#pragma unroll
            for (int ks = 0; ks < 8; ++ks) { const int n = 32 * nb + r32;
                const bf16x8 af = *(const __attribute__((address_space(3))) bf16x8*)(SKl + p * 32768 + n * 256 + (((2 * ks + hi) ^ (n & 15)) << 4));
                acc[nb] = __builtin_amdgcn_mfma_f32_32x32x16_bf16(af, qf[ks], acc[nb], 0, 0, 0); } }
        unsigned k[64];
#pragma unroll
        for (int nb = 0; nb < 4; ++nb)
#pragma unroll
            for (int r = 0; r < 16; ++r) k[16 * nb + r] = (fmap(acc[nb][r]) & ~127u) | (unsigned)(32 * nb + (r & 3) + 8 * (r >> 2)) | (unsigned)(4 * hi);
        top16_of_64(k);
        merge_halves(k, hi);
#pragma unroll
        for (int i = 0; i < 16; ++i) { if (p == 0) K0[i] = k[i]; else K1[i] = k[i]; }
    }
    { unsigned w0 = 0, w1 = 0, w2 = 0, w3 = 0;
#pragma unroll
      for (int i = 0; i < 4; ++i) { const unsigned a = hi ? K1[i] : K0[i], b = hi ? K1[4 + i] : K0[4 + i], c = hi ? K1[8 + i] : K0[8 + i], d = hi ? K1[12 + i] : K0[12 + i];
          w0 |= (a & 127u) << (8 * i); w1 |= (b & 127u) << (8 * i); w2 |= (c & 127u) << (8 * i); w3 |= (d & 127u) << (8 * i); }
      *(__attribute__((address_space(3))) v4u*)(NL + r32 * 32 + hi * 16) = (v4u){w0, w1, w2, w3}; }
    float v0[16], v1[16];
#pragma unroll
    for (int i = 0; i < 16; ++i) { v0[i] = funmap(K0[i] & ~127u); v1[i] = funmap(K1[i] & ~127u); }
    unsigned k[64];
#pragma unroll
    for (int c = 0; c < 64; ++c) { if (c < 50) { const float s = v0[CT_.i[c]] + v1[CT_.j[c]]; k[c] = (fmap(s) & ~255u) | (unsigned)(CT_.i[c] * 16 + CT_.j[c]); } else k[c] = 0u; }
    top16_of_64(k);
    float best[16]; float sum = 0.f; const float mx = funmap(k[0] & ~255u);
#pragma unroll
    for (int r = 0; r < 16; ++r) { best[r] = __expf(funmap(k[r] & ~255u) - mx); sum += best[r]; }
    const float rs = 1.0f / sum;
    asm volatile("s_waitcnt lgkmcnt(0)" ::: "memory");
    unsigned short idx[8]; float gt[8];
#pragma unroll
    for (int r = 0; r < 8; ++r) { const unsigned kk = hi ? k[8 + r] : k[r]; const float g = (hi ? best[8 + r] : best[r]) * rs;
        const unsigned n0 = NL[r32 * 32 + ((kk >> 4) & 15u)], n1 = NL[r32 * 32 + 16 + (kk & 15u)];
        idx[r] = (unsigned short)(n0 * 128u + n1); gt[r] = g; }
    v4u iw; iw.x = idx[0] | ((unsigned)idx[1] << 16); iw.y = idx[2] | ((unsigned)idx[3] << 16); iw.z = idx[4] | ((unsigned)idx[5] << 16); iw.w = idx[6] | ((unsigned)idx[7] << 16);
    const size_t t = (size_t)(t0 + r32);
    *(GAS v4u*)(IDX + t * 128 + h * 16 + 8 * hi) = iw;
    *(GAS f32x4*)(GATE + t * 128 + h * 16 + 8 * hi) = (f32x4){gt[0], gt[1], gt[2], gt[3]};
    *(GAS f32x4*)(GATE + t * 128 + h * 16 + 8 * hi + 4) = (f32x4){gt[4], gt[5], gt[6], gt[7]};
    asm volatile("s_waitcnt lgkmcnt(0)" ::: "memory");
}
}

__device__ __forceinline__ void p9_topk(Frame& F, unsigned char* ws) {
    const int h = F.vcu & 7, cg = F.vcu >> 3;
    const bf16* SK = (const bf16*)(ws + WS_SK) + (size_t)h * 32768;
    for (int g = F.tid; g < 4096; g += 512) { const int p = g >> 11, n = (g >> 4) & 127, ch = g & 15;
        *(LAS v4u*)(F.lds + p * 32768 + n * 256 + ((ch ^ (n & 15)) << 4)) = *(const GAS v4u*)(SK + (size_t)g * 8); }
    __syncthreads();
    for (int j = 0; j < 4; ++j) { const int tg = cg * 32 + F.wave * 4 + j;
        topk::task(tg * 32, h, (const bf16*)(ws + WS_QP), (unsigned short*)(ws + WS_IDX), (float*)(ws + WS_GATE), F.lds, F.lds + topk::NL_OFF + F.wave * 1024, F.lane); }
    __syncthreads();
}

typedef float f32x2v __attribute__((ext_vector_type(2)));
__device__ __forceinline__ void p10_experts(Frame& F, const In& I, unsigned char* ws, float* out) {
    const int gw = F.vcu * NWAVES + F.wave, NGW = F.G * NWAVES; const int lane = F.lane;
    const bf16* X1 = (const bf16*)(ws + WS_XB); const unsigned char* EU = ws + WS_EU; const unsigned char* EV = ws + WS_EV;
    const float* SU = (const float*)(ws + WS_SU); const float* SV = (const float*)(ws + WS_SV);
    const unsigned short* IDX = (const unsigned short*)(ws + WS_IDX); const float* GATE = (const float*)(ws + WS_GATE);
    const int sel = ((lane >> 5) & 1) * 4 + ((lane >> 4) & 1) * 2 + ((lane >> 3) & 1);
    for (int t = gw; t < T; t += NGW) {
        const v4u hb0 = *(const GAS v4u*)(X1 + (size_t)t * Dm + 16 * lane), hb1 = *(const GAS v4u*)(X1 + (size_t)t * Dm + 16 * lane + 8);
        f32x2v h[8];
        h[0] = (f32x2v){bf_lo(hb0.x), bf_hi(hb0.x)}; h[1] = (f32x2v){bf_lo(hb0.y), bf_hi(hb0.y)}; h[2] = (f32x2v){bf_lo(hb0.z), bf_hi(hb0.z)}; h[3] = (f32x2v){bf_lo(hb0.w), bf_hi(hb0.w)};
        h[4] = (f32x2v){bf_lo(hb1.x), bf_hi(hb1.x)}; h[5] = (f32x2v){bf_lo(hb1.y), bf_hi(hb1.y)}; h[6] = (f32x2v){bf_lo(hb1.z), bf_hi(hb1.z)}; h[7] = (f32x2v){bf_lo(hb1.w), bf_hi(hb1.w)};
        const unsigned ia = IDX[(size_t)t * 128 + lane], ib = IDX[(size_t)t * 128 + 64 + lane];
        const float sua = SU[ia], sub = SU[ib];
        const float gva = GATE[(size_t)t * 128 + lane] * SV[ia], gvb = GATE[(size_t)t * 128 + 64 + lane] * SV[ib];
        f32x2v acc[8];
#pragma unroll
        for (int i = 0; i < 8; ++i) acc[i] = (f32x2v){0.f, 0.f};
        int e[8]; v4u u[8];
#pragma unroll
        for (int j = 0; j < 8; ++j) { e[j] = __builtin_amdgcn_readlane(ia, j); u[j] = *(const GAS v4u*)(EU + (size_t)e[j] * 1024 + 16 * lane); }
        for (int bt = 0; bt < 16; ++bt) {
            float p[8];
#pragma unroll
            for (int j = 0; j < 8; ++j) { f32x2v s2 = (f32x2v){0.f, 0.f};
                s2 = __builtin_elementwise_fma(__builtin_amdgcn_cvt_pk_f32_fp8((int)u[j].x, false), h[0], s2); s2 = __builtin_elementwise_fma(__builtin_amdgcn_cvt_pk_f32_fp8((int)u[j].x, true), h[1], s2);
                s2 = __builtin_elementwise_fma(__builtin_amdgcn_cvt_pk_f32_fp8((int)u[j].y, false), h[2], s2); s2 = __builtin_elementwise_fma(__builtin_amdgcn_cvt_pk_f32_fp8((int)u[j].y, true), h[3], s2);
                s2 = __builtin_elementwise_fma(__builtin_amdgcn_cvt_pk_f32_fp8((int)u[j].z, false), h[4], s2); s2 = __builtin_elementwise_fma(__builtin_amdgcn_cvt_pk_f32_fp8((int)u[j].z, true), h[5], s2);
                s2 = __builtin_elementwise_fma(__builtin_amdgcn_cvt_pk_f32_fp8((int)u[j].w, false), h[6], s2); s2 = __builtin_elementwise_fma(__builtin_amdgcn_cvt_pk_f32_fp8((int)u[j].w, true), h[7], s2);
                p[j] = s2.x + s2.y; }
            v4u x[8];
#pragma unroll
            for (int j = 0; j < 8; ++j) x[j] = *(const GAS v4u*)(EV + (size_t)e[j] * 1024 + 16 * lane);
            if (bt + 1 < 16) {
#pragma unroll
                for (int j = 0; j < 8; ++j) { const int kx = 8 * (bt + 1) + j; e[j] = __builtin_amdgcn_readlane(kx < 64 ? ia : ib, kx & 63); u[j] = *(const GAS v4u*)(EU + (size_t)e[j] * 1024 + 16 * lane); }
            }
            float q4[4], q2[2], q1;
            { const bool up_ = (lane & 32) != 0;
#pragma unroll
              for (int j = 0; j < 4; ++j) { const float send = up_ ? p[j] : p[4 + j], keep = up_ ? p[4 + j] : p[j]; q4[j] = keep + __shfl_xor(send, 32); } }
            { const bool up_ = (lane & 16) != 0;
#pragma unroll
              for (int j = 0; j < 2; ++j) { const float send = up_ ? q4[j] : q4[2 + j], keep = up_ ? q4[2 + j] : q4[j]; q2[j] = keep + __shfl_xor(send, 16); } }
            { const bool up_ = (lane & 8) != 0; const float send = up_ ? q2[0] : q2[1], keep = up_ ? q2[1] : q2[0]; q1 = keep + __shfl_xor(send, 8); }
            q1 += __shfl_xor(q1, 4); q1 += __shfl_xor(q1, 2); q1 += __shfl_xor(q1, 1);
            const int kx = 8 * bt + sel;
            const float susel = __shfl(kx < 64 ? sua : sub, kx & 63), gvsel = __shfl(kx < 64 ? gva : gvb, kx & 63);
            const float wv = gelu_erf(q1 * susel) * gvsel;
#pragma unroll
            for (int j = 0; j < 8; ++j) { const float w = __builtin_bit_cast(float, __builtin_amdgcn_readlane(__builtin_bit_cast(int, wv), ((j >> 2) & 1) * 32 + ((j >> 1) & 1) * 16 + (j & 1) * 8));
                const f32x2v w2 = (f32x2v){w, w};
                acc[0] = __builtin_elementwise_fma(__builtin_amdgcn_cvt_pk_f32_fp8((int)x[j].x, false), w2, acc[0]); acc[1] = __builtin_elementwise_fma(__builtin_amdgcn_cvt_pk_f32_fp8((int)x[j].x, true), w2, acc[1]);
                acc[2] = __builtin_elementwise_fma(__builtin_amdgcn_cvt_pk_f32_fp8((int)x[j].y, false), w2, acc[2]); acc[3] = __builtin_elementwise_fma(__builtin_amdgcn_cvt_pk_f32_fp8((int)x[j].y, true), w2, acc[3]);
                acc[4] = __builtin_elementwise_fma(__builtin_amdgcn_cvt_pk_f32_fp8((int)x[j].z, false), w2, acc[4]); acc[5] = __builtin_elementwise_fma(__builtin_amdgcn_cvt_pk_f32_fp8((int)x[j].z, true), w2, acc[5]);
                acc[6] = __builtin_elementwise_fma(__builtin_amdgcn_cvt_pk_f32_fp8((int)x[j].w, false), w2, acc[6]); acc[7] = __builtin_elementwise_fma(__builtin_amdgcn_cvt_pk_f32_fp8((int)x[j].w, true), w2, acc[7]); }
        }
        float y[16];
#pragma unroll
        for (int i = 0; i < 8; ++i) { y[2 * i] = ALPHA * h[i].x + acc[i].x; y[2 * i + 1] = ALPHA * h[i].y + acc[i].y; }
        float s = 0.f;
#pragma unroll
        for (int i = 0; i < 16; ++i) s += y[i];
        const float mean = wave_sum(s) * (1.f / Dm); float s2 = 0.f;
#pragma unroll
        for (int i = 0; i < 16; ++i) { y[i] -= mean; s2 += y[i] * y[i]; }
        const float rstd = 1.f / sqrtf(wave_sum(s2) * (1.f / Dm) + LN_EPS);
#pragma unroll
        for (int c = 0; c < 4; ++c) { const int col = 16 * lane + 4 * c;
            const f32x4 g0 = *(const GAS f32x4*)(I.ln2_gain + col), b0 = *(const GAS f32x4*)(I.ln2_bias + col);
            f32x4 o0; o0.x = y[4 * c + 0] * rstd * g0.x + b0.x; o0.y = y[4 * c + 1] * rstd * g0.y + b0.y; o0.z = y[4 * c + 2] * rstd * g0.z + b0.z; o0.w = y[4 * c + 3] * rstd * g0.w + b0.w;
            *(GAS f32x4*)(out + (size_t)t * Dm + col) = o0; }
    }
}

namespace peer {
constexpr int L_IDX = 0, L_W = 32768, PEER_LDS = 98304;
typedef float f32x2v __attribute__((ext_vector_type(2)));
__device__ __forceinline__ float dot16(v4u d, const f32x2v (&h)[8]) {
    f32x2v s2 = (f32x2v){0.f, 0.f};
    s2 = __builtin_elementwise_fma(__builtin_amdgcn_cvt_pk_f32_fp8((int)d.x, false), h[0], s2); s2 = __builtin_elementwise_fma(__builtin_amdgcn_cvt_pk_f32_fp8((int)d.x, true), h[1], s2);
    s2 = __builtin_elementwise_fma(__builtin_amdgcn_cvt_pk_f32_fp8((int)d.y, false), h[2], s2); s2 = __builtin_elementwise_fma(__builtin_amdgcn_cvt_pk_f32_fp8((int)d.y, true), h[3], s2);
    s2 = __builtin_elementwise_fma(__builtin_amdgcn_cvt_pk_f32_fp8((int)d.z, false), h[4], s2); s2 = __builtin_elementwise_fma(__builtin_amdgcn_cvt_pk_f32_fp8((int)d.z, true), h[5], s2);
    s2 = __builtin_elementwise_fma(__builtin_amdgcn_cvt_pk_f32_fp8((int)d.w, false), h[6], s2); s2 = __builtin_elementwise_fma(__builtin_amdgcn_cvt_pk_f32_fp8((int)d.w, true), h[7], s2);
    return s2.x + s2.y;
}
__device__ __forceinline__ unsigned idx_of(const v4u& a, const v4u& b, int slot) { const unsigned w = slot < 8 ? a[slot >> 1] : b[(slot - 8) >> 1]; return (slot & 1) ? (w >> 16) : (w & 0xffffu); }

__device__ __forceinline__ void run(Frame& F, const In& I, unsigned char* ws, float* out) {
    const int tid = F.tid, lane = F.lane, wave = F.wave, g = lane >> 3, j = lane & 7;
    const int t0 = F.vcu * 128;
    const bf16* X1 = (const bf16*)(ws + WS_XB); const unsigned char* EU = ws + WS_EU; const unsigned char* EV = ws + WS_EV;
    const float* SU = (const float*)(ws + WS_SU); const float* SV = (const float*)(ws + WS_SV);
    const unsigned short* IDX = (const unsigned short*)(ws + WS_IDX); const float* GATE = (const float*)(ws + WS_GATE);
    LAS unsigned char* lds = F.lds;
    for (int q = tid; q < 128 * 16; q += 512) { const int tok = q >> 4, slot = q & 15; const v4u w8 = *(const GAS v4u*)(IDX + (size_t)(t0 + tok) * 128 + slot * 8);
        LAS unsigned short* dst = (LAS unsigned short*)(lds + L_IDX) + tok * 128 + slot;
        dst[0 * 16] = (unsigned short)(w8.x & 0xffffu); dst[1 * 16] = (unsigned short)(w8.x >> 16); dst[2 * 16] = (unsigned short)(w8.y & 0xffffu); dst[3 * 16] = (unsigned short)(w8.y >> 16);
        dst[4 * 16] = (unsigned short)(w8.z & 0xffffu); dst[5 * 16] = (unsigned short)(w8.z >> 16); dst[6 * 16] = (unsigned short)(w8.w & 0xffffu); dst[7 * 16] = (unsigned short)(w8.w >> 16); }
    __syncthreads();
    for (int s = 0; s < 8; ++s) {
        for (int i = 0; i < 16; ++i) {
            const int tok = wave * 16 + i; const size_t t = (size_t)(t0 + tok);
            const v4u ix0 = *(const LAS v4u*)(lds + L_IDX + tok * 256 + g * 32), ix1 = *(const LAS v4u*)(lds + L_IDX + tok * 256 + g * 32 + 16);
            const v4u hb0 = *(const GAS v4u*)(X1 + t * Dm + 128 * s + 16 * j), hb1 = *(const GAS v4u*)(X1 + t * Dm + 128 * s + 16 * j + 8);
            v4u d[16];
#pragma unroll
            for (int sl = 0; sl < 16; ++sl) d[sl] = *(const GAS v4u*)(EU + (size_t)idx_of(ix0, ix1, sl) * 1024 + 128 * s + 16 * j);
            f32x2v h[8];
            h[0] = (f32x2v){bf_lo(hb0.x), bf_hi(hb0.x)}; h[1] = (f32x2v){bf_lo(hb0.y), bf_hi(hb0.y)}; h[2] = (f32x2v){bf_lo(hb0.z), bf_hi(hb0.z)}; h[3] = (f32x2v){bf_lo(hb0.w), bf_hi(hb0.w)};
            h[4] = (f32x2v){bf_lo(hb1.x), bf_hi(hb1.x)}; h[5] = (f32x2v){bf_lo(hb1.y), bf_hi(hb1.y)}; h[6] = (f32x2v){bf_lo(hb1.z), bf_hi(hb1.z)}; h[7] = (f32x2v){bf_lo(hb1.w), bf_hi(hb1.w)};
            float p[16];
#pragma unroll
            for (int sl = 0; sl < 16; ++sl) p[sl] = dot16(d[sl], h);
            float p8[8], p4[4]; f32x2v r;
            { const bool up_ = (lane & 4) != 0;
#pragma unroll
              for (int q = 0; q < 8; ++q) { const float send = up_ ? p[q] : p[8 + q], keep = up_ ? p[8 + q] : p[q]; p8[q] = keep + __shfl_xor(send, 4); } }
            { const bool up_ = (lane & 2) != 0;
#pragma unroll
              for (int q = 0; q < 4; ++q) { const float send = up_ ? p8[q] : p8[4 + q], keep = up_ ? p8[4 + q] : p8[q]; p4[q] = keep + __shfl_xor(send, 2); } }
            { const bool up_ = (lane & 1) != 0;
              const float s0 = up_ ? p4[0] : p4[2], k0 = up_ ? p4[2] : p4[0], s1 = up_ ? p4[1] : p4[3], k1 = up_ ? p4[3] : p4[1];
              r.x = k0 + __shfl_xor(s0, 1); r.y = k1 + __shfl_xor(s1, 1); }
            LAS f32x2v* zp = (LAS f32x2v*)(lds + L_W + tok * 512 + g * 64 + j * 8);
            if (s == 0) *zp = r; else *zp = *zp + r;
        }
    }
    for (int i = 0; i < 16; ++i) {
        const int tok = wave * 16 + i; const size_t t = (size_t)(t0 + tok);
        LAS f32x2v* zp = (LAS f32x2v*)(lds + L_W + tok * 512 + g * 64 + j * 8); const f32x2v z = *zp;
        const unsigned ip = *(const LAS unsigned*)(lds + L_IDX + tok * 256 + g * 32 + j * 4); const unsigned e0 = ip & 0xffffu, e1 = ip >> 16;
        const float g0 = GATE[t * 128 + (2 * j) * 8 + g], g1 = GATE[t * 128 + (2 * j + 1) * 8 + g];
        f32x2v w; w.x = gelu_erf(z.x * SU[e0]) * g0 * SV[e0]; w.y = gelu_erf(z.y * SU[e1]) * g1 * SV[e1];
        *zp = w;
    }
    asm volatile("s_waitcnt lgkmcnt(0)" ::: "memory");
    for (int s = 0; s < 8; ++s) {
        for (int i = 0; i < 16; ++i) {
            const int tok = wave * 16 + i; const size_t t = (size_t)(t0 + tok);
            const v4u ix0 = *(const LAS v4u*)(lds + L_IDX + tok * 256 + g * 32), ix1 = *(const LAS v4u*)(lds + L_IDX + tok * 256 + g * 32 + 16);
            v4u d[16];
#pragma unroll
            for (int sl = 0; sl < 16; ++sl) d[sl] = *(const GAS v4u*)(EV + (size_t)idx_of(ix0, ix1, sl) * 1024 + 128 * s + 16 * j);
            const unsigned hres = *(const GAS unsigned*)(X1 + t * Dm + 128 * s + 16 * j + 2 * g);
            f32x4 wq[4];
#pragma unroll
            for (int q = 0; q < 4; ++q) wq[q] = *(const LAS f32x4*)(lds + L_W + tok * 512 + g * 64 + q * 16);
            f32x2v acc[8];
#pragma unroll
            for (int q = 0; q < 8; ++q) acc[q] = (f32x2v){0.f, 0.f};
#pragma unroll
            for (int sl = 0; sl < 16; ++sl) { const float w = wq[sl >> 2][sl & 3]; const f32x2v w2 = (f32x2v){w, w}; const v4u x = d[sl];
                acc[0] = __builtin_elementwise_fma(__builtin_amdgcn_cvt_pk_f32_fp8((int)x.x, false), w2, acc[0]); acc[1] = __builtin_elementwise_fma(__builtin_amdgcn_cvt_pk_f32_fp8((int)x.x, true), w2, acc[1]);
                acc[2] = __builtin_elementwise_fma(__builtin_amdgcn_cvt_pk_f32_fp8((int)x.y, false), w2, acc[2]); acc[3] = __builtin_elementwise_fma(__builtin_amdgcn_cvt_pk_f32_fp8((int)x.y, true), w2, acc[3]);
                acc[4] = __builtin_elementwise_fma(__builtin_amdgcn_cvt_pk_f32_fp8((int)x.z, false), w2, acc[4]); acc[5] = __builtin_elementwise_fma(__builtin_amdgcn_cvt_pk_f32_fp8((int)x.z, true), w2, acc[5]);
                acc[6] = __builtin_elementwise_fma(__builtin_amdgcn_cvt_pk_f32_fp8((int)x.w, false), w2, acc[6]); acc[7] = __builtin_elementwise_fma(__builtin_amdgcn_cvt_pk_f32_fp8((int)x.w, true), w2, acc[7]); }
            f32x2v a4[4], a2[2], r;
            { const bool up_ = (lane & 32) != 0;
#pragma unroll
              for (int q = 0; q < 4; ++q) { const f32x2v send = up_ ? acc[q] : acc[4 + q], keep = up_ ? acc[4 + q] : acc[q]; a4[q].x = keep.x + __shfl_xor(send.x, 32); a4[q].y = keep.y + __shfl_xor(send.y, 32); } }
            { const bool up_ = (lane & 16) != 0;
#pragma unroll
              for (int q = 0; q < 2; ++q) { const f32x2v send = up_ ? a4[q] : a4[2 + q], keep = up_ ? a4[2 + q] : a4[q]; a2[q].x = keep.x + __shfl_xor(send.x, 16); a2[q].y = keep.y + __shfl_xor(send.y, 16); } }
            { const bool up_ = (lane & 8) != 0; const f32x2v send = up_ ? a2[0] : a2[1], keep = up_ ? a2[1] : a2[0]; r.x = keep.x + __shfl_xor(send.x, 8); r.y = keep.y + __shfl_xor(send.y, 8); }
            f32x2v y; y.x = ALPHA * bf_lo(hres) + r.x; y.y = ALPHA * bf_hi(hres) + r.y;
            *(GAS f32x2v*)(out + t * Dm + 128 * s + 16 * j + 2 * g) = y;
        }
    }
    asm volatile("s_waitcnt vmcnt(0)" ::: "memory");
    for (int i = 0; i < 16; ++i) {
        const size_t t = (size_t)(t0 + wave * 16 + i);
        GAS f32x4* yr = (GAS f32x4*)(out + t * Dm) + lane;
        f32x4 v[4]; float sm = 0.f;
#pragma unroll
        for (int q = 0; q < 4; ++q) { v[q] = yr[64 * q]; sm += (v[q].x + v[q].y) + (v[q].z + v[q].w); }
        const float mean = wave_sum(sm) * (1.f / Dm); float s2 = 0.f;
#pragma unroll
        for (int q = 0; q < 4; ++q) { v[q] = v[q] - mean; s2 += (v[q].x * v[q].x + v[q].y * v[q].y) + (v[q].z * v[q].z + v[q].w * v[q].w); }
        const float rstd = 1.f / sqrtf(wave_sum(s2) * (1.f / Dm) + LN_EPS);
#pragma unroll
        for (int q = 0; q < 4; ++q) { const f32x4 gq = *((const GAS f32x4*)I.ln2_gain + lane + 64 * q), bq = *((const GAS f32x4*)I.ln2_bias + lane + 64 * q); yr[64 * q] = v[q] * rstd * gq + bq; }
    }
}
}

struct Args { const float* in[17]; float* out; unsigned char* ws; int ph_lo, ph_hi, li, pad; };
__global__ void __launch_bounds__(NWAVES * 64, 2) mk_fwd(Args args) {
    extern __shared__ __attribute__((aligned(16))) unsigned char lds[];
    Frame F;
    F.lds = (LAS unsigned char*)lds;
    F.MISC = (volatile LAS unsigned*)(F.lds + MISC_OFF);
    F.tid = threadIdx.x; F.lane = F.tid & 63; F.wave = __builtin_amdgcn_readfirstlane(F.tid >> 6);
    F.G = gridDim.x; { const int bx = blockIdx.x; F.vcu = (F.G % 8 == 0) ? (bx % 8) * (F.G / 8) + bx / 8 : bx; }
    unsigned char* ws = args.ws;
    F.ctl = (gu32*)(ws + WS_CTL);
    In I; I.x = args.in[0]; I.w_in = args.in[1]; I.fox_f_bias = args.in[2]; I.gla_gate_up = args.in[3]; I.gla_gate_bias = args.in[4]; I.gla_norm_gain = args.in[5];
    I.w_out_fox = args.in[6]; I.w_out_gla = args.in[7]; I.w_out = args.in[8]; I.ln1_gain = args.in[9]; I.ln1_bias = args.in[10]; I.peer_w_query = args.in[11];
    I.peer_sub_keys = args.in[12]; I.peer_expert_u = args.in[13]; I.peer_expert_v = args.in[14]; I.ln2_gain = args.in[15]; I.ln2_bias = args.in[16];
    for (int u = F.tid; u < (LDS_BYTES - LDSCTL_OFF) / 4; u += NWAVES * 64) ((LAS unsigned*)(F.lds + LDSCTL_OFF))[u] = 0u;
    __syncthreads();
    XcdBarrier bar = xcd_barrier_post((unsigned*)(F.ctl + CW_BAR) + args.li * XCD_BAR_WORDS, F.MISC + 8);
    const int lo = args.ph_lo, hi = args.ph_hi;
#ifndef MK_ONLY
#define MK_ONLY -1
#endif
#define IN(k) ((MK_ONLY < 0 || MK_ONLY == (k)) && lo <= (k) && (k) < hi)
#if defined(MK_TIME_A)
    unsigned long long stamps_[N_PHASES + 1]; const bool stamper_ = (blockIdx.x == 0 && F.tid == 0);
#define STAMP(k) do { __builtin_amdgcn_sched_barrier(0); { unsigned long long t_; asm volatile("s_memrealtime %0\n\ts_waitcnt lgkmcnt(0)" : "=s"(t_) :: "memory"); if (stamper_) stamps_[k] = t_; } __builtin_amdgcn_sched_barrier(0); } while (0)
#else
#define STAMP(k) do { } while (0)
#endif
#define SEAM(k) do { if (IN(k) && IN((k) + 1)) xcd_barrier(bar); STAMP((k) + 1); } while (0)
    STAMP(0);

    if (IN(0)) { p0_prologue(F, I, ws); } SEAM(0);

    if (IN(1)) {
        p1_forget_cumsum(F, I, ws);
        pg8::Gemm g{(const pg8::bf16_t*)(ws + WS_XB), (const pg8::bf16_t*)(ws + WS_WIN), T, NPROJ, Dm}; pg8::StaticOrder S; S.init(T, NPROJ, F.G, (int)blockIdx.x);
        pg8::EpiProj E{ws, (unsigned char*)args.out};
        pg8::gemm_phase<pg8::EpiProj, pg8::StaticOrder, true, true>(F.lds, g, S, E);
    } SEAM(1);

    unsigned long long gla_tacc = 0;
    if (IN(2)) {
        const int g4 = F.vcu & 3;
        if (g4 == 0) {
            const int u = F.vcu >> 2;
            gla::gla_unit(u >> 2, u & 3, (const bf16*)(ws + WS_GQ), (const bf16*)(ws + WS_GK), (const bf16*)(ws + WS_GV), (const bf16*)(ws + WS_GG), (const float*)(ws + WS_GLR),
                          I.gla_gate_up, I.gla_gate_bias, I.gla_norm_gain, (bf16*)(ws + WS_GV), F.lds, gla_tacc);
        } else {
            const int f = (F.vcu >> 2) * 3 + (g4 - 1), pair = f / 3, role = f % 3, bh0 = 2 * pair, bh1 = bh0 + 1;
            const int n = role == 2 ? 8 : 4;
            for (int i = 0; i < n; ++i) {
                int bh, qb;
                if (role == 0)      { bh = (i & 1) ? bh1 : bh0; qb = i == 0 ? 7 : i == 1 ? 7 : i == 2 ? 6 : 0; }
                else if (role == 1) { bh = (i & 1) ? bh0 : bh1; qb = i == 0 ? 6 : i == 1 ? 5 : i == 2 ? 5 : 4; }
                else                { bh = (i & 1) ? bh0 : bh1; qb = 4 - ((i + 1) >> 1); }
                fox::attn64_unit(bh >> 3, bh & 7, qb, (const fox::bf16*)(ws + WS_FQ), (const fox::bf16*)(ws + WS_FK), (const fox::bf16*)(ws + WS_FV), (fox::bf16*)(ws + WS_FQ),
                                 (const float*)(ws + WS_CB), (char*)lds);
            }
        }
    }
    STAMP(3);
    SEAM(3);

    if (IN(4)) {
        pg8::Gemm g{(const pg8::bf16_t*)(ws + WS_FQ), (const pg8::bf16_t*)(ws + WS_WOF), T, Dm, 512}; pg8::StaticOrder S; S.init(T, Dm, F.G, (int)blockIdx.x);
        pg8::EpiGate<0> E{(const pg8::bf16_t*)args.out, (pg8::bf16_t*)(ws + WS_XB)};
        pg8::gemm_phase<pg8::EpiGate<0>, pg8::StaticOrder, true, true>(F.lds, g, S, E);
    } SEAM(4);
    if (IN(5)) {
        pg8::Gemm g{(const pg8::bf16_t*)(ws + WS_GV), (const pg8::bf16_t*)(ws + WS_WOG), T, Dm, Dm}; pg8::StaticOrder S; S.init(T, Dm, F.G, (int)blockIdx.x);
        pg8::EpiGate<1> E{(const pg8::bf16_t*)((unsigned char*)args.out + 64 * MiB), (pg8::bf16_t*)(ws + WS_XB)};
        pg8::gemm_phase<pg8::EpiGate<1>, pg8::StaticOrder, true, true>(F.lds, g, S, E);
    } SEAM(5);
    if (IN(6)) {
        pg8::Gemm g{(const pg8::bf16_t*)(ws + WS_XB), (const pg8::bf16_t*)(ws + WS_WO), T, Dm, Dm}; pg8::StaticOrder S; S.init(T, Dm, F.G, (int)blockIdx.x);
        pg8::EpiMix E{I.x, (float*)(ws + WS_Y)};
        pg8::gemm_phase<pg8::EpiMix, pg8::StaticOrder, true, true>(F.lds, g, S, E);
    } SEAM(6);
    if (IN(7)) { p7_ln1(F, I, ws); } SEAM(7);
    if (IN(8)) {
        pg8::Gemm g{(const pg8::bf16_t*)(ws + WS_XB), (const pg8::bf16_t*)(ws + WS_WQ), T, 2048, Dm}; pg8::StaticOrder S; S.init(T, 2048, F.G, (int)blockIdx.x);
        pg8::EpiBf16<0> E{(pg8::bf16_t*)(ws + WS_QP), 2048, nullptr, 0, 0, 1.f};
        pg8::gemm_phase<pg8::EpiBf16<0>, pg8::StaticOrder, true, true>(F.lds, g, S, E);
    } SEAM(8);
    if (IN(9)) { p9_topk(F, ws); } SEAM(9);
#if defined(MK_P10_FLAT)
    if (IN(10)) { p10_experts(F, I, ws, args.out); }
#else
    if (IN(10)) { peer::run(F, I, ws, args.out); }
#endif
#if defined(MK_TIME_A)
    xcd_barrier(bar);
    STAMP(N_PHASES);
    if (stamper_) { const unsigned long long t1 = stamps_[N_PHASES];
#if defined(MK_GLA_T)
        const unsigned long long d = gla_tacc * MK_TIME_K;
#else
        const unsigned long long d = (stamps_[MK_TIME_B] - stamps_[MK_TIME_A]) * MK_TIME_K;
#endif
        while (rt() - t1 < d) __builtin_amdgcn_s_sleep(8); }
#endif
#undef IN
#undef SEAM
}

extern "C" void kernel_launch(void* const* d_in, const int* in_sizes, int n_in, void* d_out, int out_size, void* d_ws, size_t ws_size, hipStream_t stream) {
    static int grid = 0;
    if (grid == 0) {
        if (n_in != 17 || in_sizes[0] != T * Dm || out_size != T * Dm || ws_size < WS_END) { fprintf(stderr, "kernel_launch: unexpected shapes or workspace (n_in %d, in0 %d, out %d, ws %zu)\n", n_in, n_in > 0 ? in_sizes[0] : -1, out_size, ws_size); grid = -1; return; }
        int dev = 0, cus = 0, per_cu = 0;
        if (hipGetDevice(&dev) != hipSuccess || hipDeviceGetAttribute(&cus, hipDeviceAttributeMultiprocessorCount, dev) != hipSuccess) { grid = -1; return; }
        if (hipFuncSetAttribute((const void*)mk_fwd, hipFuncAttributeMaxDynamicSharedMemorySize, LDS_BYTES) != hipSuccess) { fprintf(stderr, "kernel_launch: hipFuncSetAttribute failed\n"); grid = -1; return; }
        if (hipOccupancyMaxActiveBlocksPerMultiprocessor(&per_cu, (const void*)mk_fwd, NWAVES * 64, LDS_BYTES) != hipSuccess || per_cu < 1) fprintf(stderr, "kernel_launch: occupancy query reports %d\n", per_cu);
        (void)hipGetLastError();
        grid = cus;
        if (grid != 256) { fprintf(stderr, "kernel_launch: built for 256 CUs, found %d\n", grid); grid = -1; return; }
    }
    if (grid < 0) return;
    if (hipMemsetAsync((char*)d_ws + WS_CTL, 0, CTL_ZERO_BYTES, stream) != hipSuccess) return;
    Args a{};
    for (int i = 0; i < 17; ++i) a.in[i] = (const float*)d_in[i];
    a.out = (float*)d_out; a.ws = (unsigned char*)d_ws;
#if MK_N_LAUNCHES == 1
    a.ph_lo = 0; a.ph_hi = N_PHASES; a.li = 0;
    hipLaunchKernelGGL(mk_fwd, dim3(grid), dim3(NWAVES * 64), LDS_BYTES, stream, a);
#else
    for (int li = 0; li < N_PHASES; ++li) { a.ph_lo = li; a.ph_hi = li + 1; a.li = li; if (li == 2) { a.ph_hi = 4; } if (li == 3) continue;
        hipLaunchKernelGGL(mk_fwd, dim3(grid), dim3(NWAVES * 64), LDS_BYTES, stream, a); }
#endif
}
```
